# Optimizing an MI355X kernel written in HIP

```python
import jax, jax.numpy as jnp
from jax import lax
import numpy as np


D_MODEL = 1024
BATCH = 1
SEQ = 16384
DEPTH = 2

CHUNK = 64
N_A_LAYERS = DEPTH // 2
N_B_LAYERS = DEPTH - N_A_LAYERS
EPS = 1e-6

GLA_HEADS = 4
GLA_DK = D_MODEL // 2
GLA_DV = D_MODEL
GLA_HK = GLA_DK // GLA_HEADS
GLA_HV = GLA_DV // GLA_HEADS
GLA_GATE_RANK = 16
GLA_TAU = 16.0
GLA_IN = 2 * GLA_DK + 2 * GLA_DV + GLA_GATE_RANK

MLA_HEADS = 16
MLA_NOPE = 64
MLA_ROPE = 32
MLA_QK = MLA_NOPE + MLA_ROPE
MLA_V = 64
MLA_Q_RANK = 384
MLA_KV_RANK = 256
ROPE_THETA = 10000.0
Q_BLOCK = 128

FFN_HIDDEN = -(-8 * D_MODEL // (3 * 256)) * 256

kernel_name = 'yoco_gla_mla_hybrid'


def rms_norm(x, g):
    xf = x.astype(jnp.float32)
    y = xf * lax.rsqrt(jnp.mean(xf * xf, axis=-1, keepdims=True) + EPS)
    return (y * g.astype(jnp.float32)).astype(x.dtype)


def rope(x, positions):
    half = x.shape[-1] // 2
    inv_freq = ROPE_THETA ** (-jnp.arange(half, dtype=jnp.float32) / half)
    ang = positions.astype(jnp.float32)[:, None, :, None] * inv_freq
    cos, sin = jnp.cos(ang), jnp.sin(ang)
    xf = x.astype(jnp.float32)
    x1, x2 = xf[..., :half], xf[..., half:]
    return jnp.concatenate([x1 * cos - x2 * sin, x1 * sin + x2 * cos], axis=-1).astype(x.dtype)


def gla_mixer(h, w_in, w_gate_up, b_gate, out_norm, w_out):
    B, S, _ = h.shape
    N = S // CHUNK
    f32 = jnp.float32
    proj = h @ w_in
    q = proj[..., :GLA_DK]
    k = proj[..., GLA_DK:2 * GLA_DK]
    v = proj[..., 2 * GLA_DK:2 * GLA_DK + GLA_DV]
    r = proj[..., 2 * GLA_DK + GLA_DV:2 * GLA_DK + 2 * GLA_DV]
    gl = proj[..., 2 * GLA_DK + 2 * GLA_DV:]
    log_a = jax.nn.log_sigmoid((gl @ w_gate_up + b_gate).astype(f32)) / GLA_TAU

    def chunks(t, d):
        return t.astype(f32).reshape(B, N, CHUNK, GLA_HEADS, d).transpose(0, 3, 1, 2, 4)

    qc = chunks(q, GLA_HK) * (GLA_HK ** -0.5)
    kc = chunks(k, GLA_HK)
    vc = chunks(v, GLA_HV)
    b = jnp.cumsum(chunks(log_a, GLA_HK), axis=3)
    b_last = b[:, :, :, -1:, :]
    q_dec = qc * jnp.exp(b)
    k_inv = kc * jnp.exp(-b)
    k_end = kc * jnp.exp(b_last - b)
    causal = jnp.tril(jnp.ones((CHUNK, CHUNK), dtype=bool))
    attn = jnp.where(causal, jnp.einsum('bhnik,bhnjk->bhnij', q_dec, k_inv), 0.0)
    o_intra = jnp.einsum('bhnij,bhnjv->bhniv', attn, vc)
    kv_chunk = jnp.einsum('bhnjk,bhnjv->nbhkv', k_end, vc)
    decay = jnp.exp(b_last[:, :, :, 0, :]).transpose(2, 0, 1, 3)

    def step(state, inp):
        dec, kv = inp
        return dec[..., None] * state + kv, state

    _, s_prev = lax.scan(step, jnp.zeros((B, GLA_HEADS, GLA_HK, GLA_HV), f32), (decay, kv_chunk))
    o_inter = jnp.einsum('bhnik,nbhkv->bhniv', q_dec, s_prev)
    o = (o_intra + o_inter).transpose(0, 2, 3, 1, 4).reshape(B, S, GLA_HEADS, GLA_HV)
    o = rms_norm(o, out_norm).reshape(B, S, GLA_DV) * jax.nn.silu(r.astype(f32))
    return o.astype(h.dtype) @ w_out


def mla_shared_kv(h, positions, kv_norm, w_down, latent_norm, w_up, k_norm):
    B, S, _ = h.shape
    d = rms_norm(h, kv_norm) @ w_down
    c_kv = rms_norm(d[..., :MLA_KV_RANK], latent_norm)
    k_rope = d[..., MLA_KV_RANK:]
    kv = (c_kv @ w_up).reshape(B, S, MLA_HEADS, MLA_NOPE + MLA_V)
    k_nope, v = kv[..., :MLA_NOPE], kv[..., MLA_NOPE:]
    k = jnp.concatenate([k_nope, jnp.broadcast_to(k_rope[:, :, None, :], (B, S, MLA_HEADS, MLA_ROPE))], axis=-1)
    k = rms_norm(k, k_norm).transpose(0, 2, 1, 3)
    k = jnp.concatenate([k[..., :MLA_NOPE], rope(k[..., MLA_NOPE:], positions)], axis=-1)
    return k, v.transpose(0, 2, 1, 3)


def mla_mixer(h, positions, k, v, w_dq, q_latent_norm, w_uq, q_norm, w_out):
    B, S, _ = h.shape
    f32 = jnp.float32
    c_q = rms_norm(h @ w_dq, q_latent_norm)
    q = (c_q @ w_uq).reshape(B, S, MLA_HEADS, MLA_QK)
    q = rms_norm(q, q_norm).transpose(0, 2, 1, 3)
    q = jnp.concatenate([q[..., :MLA_NOPE], rope(q[..., MLA_NOPE:], positions)], axis=-1)
    nb = S // Q_BLOCK
    q_blocks = q.astype(f32).reshape(B, MLA_HEADS, nb, Q_BLOCK, MLA_QK).transpose(2, 0, 1, 3, 4)
    kf, vf = k.astype(f32), v.astype(f32)
    key_chunk = jnp.arange(S) // CHUNK
    scale = MLA_QK ** -0.5

    def attend(args):
        qb, blk = args
        q_chunk = (blk * Q_BLOCK + jnp.arange(Q_BLOCK)) // CHUNK
        s = jnp.einsum('bhqd,bhkd->bhqk', qb, kf) * scale
        s = jnp.where(key_chunk[None, :] <= q_chunk[:, None], s, -jnp.inf)
        p = jax.nn.softmax(s, axis=-1)
        return jnp.einsum('bhqk,bhkv->bhqv', p, vf)

    o = lax.map(attend, (q_blocks, jnp.arange(nb)))
    o = o.transpose(1, 0, 3, 2, 4).reshape(B, S, MLA_HEADS * MLA_V)
    return o.astype(h.dtype) @ w_out


def swiglu(h, w_in, w_out):
    gu = h @ w_in
    return (jax.nn.silu(gu[..., :FFN_HIDDEN]) * gu[..., FFN_HIDDEN:]) @ w_out


def setup_inputs(seed: int = 0) -> dict:
    key = jax.random.key(seed)
    ks = jax.random.split(key, 24)
    f32 = jnp.float32
    na, nb = N_A_LAYERS, N_B_LAYERS
    out_scale = (2.0 * DEPTH) ** -0.5

    def w(k, shape, fan_in, scale=1.0):
        return jax.random.normal(k, shape, f32) * (scale * fan_in ** -0.5)

    def gain(k, shape):
        return 1.0 + 0.02 * jax.random.normal(k, shape, f32)

    x = jax.random.normal(ks[0], (BATCH, SEQ, D_MODEL), f32)
    start = jax.random.randint(ks[1], (BATCH, 1), 0, 4096, dtype=jnp.int32)
    positions = start + jnp.arange(SEQ, dtype=jnp.int32)[None, :]
    return {
        'x': x,
        'positions': positions,
        'a_norm': gain(ks[2], (na, D_MODEL)),
        'a_w_in': w(ks[3], (na, D_MODEL, GLA_IN), D_MODEL),
        'a_w_gate_up': w(ks[4], (na, GLA_GATE_RANK, GLA_DK), GLA_GATE_RANK),
        'a_b_gate': 0.1 * jax.random.normal(ks[5], (na, GLA_DK), f32),
        'a_out_norm': gain(ks[6], (na, GLA_HV)),
        'a_w_out': w(ks[7], (na, GLA_DV, D_MODEL), GLA_DV, out_scale),
        'b_norm': gain(ks[8], (nb, D_MODEL)),
        'b_w_dq': w(ks[9], (nb, D_MODEL, MLA_Q_RANK), D_MODEL),
        'b_q_latent_norm': gain(ks[10], (nb, MLA_Q_RANK)),
        'b_w_uq': w(ks[11], (nb, MLA_Q_RANK, MLA_HEADS * MLA_QK), MLA_Q_RANK),
        'b_q_norm': gain(ks[12], (nb, MLA_QK)),
        'b_w_out': w(ks[13], (nb, MLA_HEADS * MLA_V, D_MODEL), MLA_HEADS * MLA_V, out_scale),
        'kv_norm': gain(ks[14], (D_MODEL,)),
        'kv_w_down': w(ks[15], (D_MODEL, MLA_KV_RANK + MLA_ROPE), D_MODEL),
        'kv_latent_norm': gain(ks[16], (MLA_KV_RANK,)),
        'kv_w_up': w(ks[17], (MLA_KV_RANK, MLA_HEADS * (MLA_NOPE + MLA_V)), MLA_KV_RANK),
        'k_norm': gain(ks[18], (MLA_QK,)),
        'f_norm': gain(ks[19], (DEPTH, D_MODEL)),
        'f_w_in': w(ks[20], (DEPTH, D_MODEL, 2 * FFN_HIDDEN), D_MODEL),
        'f_w_out': w(ks[21], (DEPTH, FFN_HIDDEN, D_MODEL), FFN_HIDDEN, out_scale),
    }


def reference(x, positions, a_norm, a_w_in, a_w_gate_up, a_b_gate, a_out_norm, a_w_out,
              b_norm, b_w_dq, b_q_latent_norm, b_w_uq, b_q_norm, b_w_out,
              kv_norm, kv_w_down, kv_latent_norm, kv_w_up, k_norm,
              f_norm, f_w_in, f_w_out):
    k_sh, v_sh = None, None
    for layer in range(DEPTH):
        if layer < N_A_LAYERS:
            i = layer
            x = x + gla_mixer(rms_norm(x, a_norm[i]), a_w_in[i], a_w_gate_up[i], a_b_gate[i],
                              a_out_norm[i], a_w_out[i])
        else:
            j = layer - N_A_LAYERS
            x = x + mla_mixer(rms_norm(x, b_norm[j]), positions, k_sh, v_sh, b_w_dq[j],
                              b_q_latent_norm[j], b_w_uq[j], b_q_norm[j], b_w_out[j])
        x = x + swiglu(rms_norm(x, f_norm[layer]), f_w_in[layer], f_w_out[layer])
        if layer == N_A_LAYERS - 1 and N_B_LAYERS > 0:
            k_sh, v_sh = mla_shared_kv(x, positions, kv_norm, kv_w_down, kv_latent_norm, kv_w_up, k_norm)
    return x
```

```cpp
#include <hip/hip_runtime.h>
#include <hip/hip_cooperative_groups.h>
#include <stdint.h>
#include <stdio.h>
#include <string.h>
#include <math.h>
namespace cg = cooperative_groups;

#ifndef MULTI_LAUNCH
#define MULTI_LAUNCH 0
#endif

typedef unsigned short bf16_t;
typedef short bf16x8 __attribute__((ext_vector_type(8)));
typedef float f32x2 __attribute__((ext_vector_type(2)));
typedef float f32x4 __attribute__((ext_vector_type(4)));
typedef float f32x16 __attribute__((ext_vector_type(16)));
typedef unsigned u32x2 __attribute__((ext_vector_type(2)));
typedef unsigned u32x4 __attribute__((ext_vector_type(4)));
typedef __bf16 bf16v2 __attribute__((ext_vector_type(2)));

#define DI __device__ __forceinline__
DI unsigned pack2(float a, float b) { f32x2 v = {a, b}; return __builtin_bit_cast(unsigned, __builtin_convertvector(v, bf16v2)); }
DI bf16_t f2bf(float a) { return (bf16_t)(pack2(a, 0.f) & 0xffffu); }
DI float bf2f(bf16_t v) { return __uint_as_float(((unsigned)v) << 16); }
DI float bflo(unsigned u) { return __uint_as_float(u << 16); }
DI float bfhi(unsigned u) { return __uint_as_float(u & 0xffff0000u); }
DI f32x4 mfma16(bf16x8 a, bf16x8 b, f32x4 c) { return __builtin_amdgcn_mfma_f32_16x16x32_bf16(a, b, c, 0, 0, 0); }
DI f32x16 mfma32(bf16x8 a, bf16x8 b, f32x16 c) { return __builtin_amdgcn_mfma_f32_32x32x16_bf16(a, b, c, 0, 0, 0); }
DI float nopack(float x) { asm("" : "+v"(x)); return x; }
DI float siluf(float x) { return x * __builtin_amdgcn_rcpf(1.f + __expf(-x)); }
DI int tid_fresh() { int t = threadIdx.x; asm volatile("" : "+v"(t)); return t; }


#define XB_TMO      128
#define XB_XCNT(j)  (256  + 64 * (j))
#define XB_XSUB(j)  (1280 + 64 * (j))
#define XB_XGEN(j)  (2304 + 64 * (j))
#define XB_TOP      3328
#define XB_TOPGEN   3392
#define XCD_BAR_WORDS 3456
#define XB_SPIN_CAP (1u << 22)
#define LAS __attribute__((address_space(3)))
DI unsigned xb_ld(unsigned* p)              { return __hip_atomic_load(p, __ATOMIC_RELAXED, __HIP_MEMORY_SCOPE_AGENT); }
DI unsigned xb_add(unsigned* p, unsigned v) { return __hip_atomic_fetch_add(p, v, __ATOMIC_RELAXED, __HIP_MEMORY_SCOPE_AGENT); }
DI unsigned xb_xcc_id() { return (unsigned)__builtin_amdgcn_s_getreg((3 << 11) | 20) & 0xFu; }
#define XB_SPIN(cond, bar) do { unsigned _sp = 0; while (cond) { __builtin_amdgcn_s_sleep(1); \
    if ((++_sp & 255u) == 0u) { if (xb_ld(&(bar)[XB_TMO])) break; if (_sp > XB_SPIN_CAP) { atomicAdd(&(bar)[XB_TMO], 1u); break; } } } } while (0)
struct XcdBarrier { unsigned* bar; unsigned x; volatile LAS unsigned* st; };
DI XcdBarrier xcd_barrier_post(unsigned* bar, volatile LAS unsigned* st) {
    XcdBarrier b; b.bar = bar; b.x = xb_xcc_id(); b.st = st;
    if (threadIdx.x == 0) (void)xb_add(&bar[XB_XCNT(b.x)], 1u);
    return b;
}
DI void xcd_barrier_complete(unsigned* bar, unsigned x, unsigned& nloc, unsigned& nx) {
    const unsigned G = gridDim.x * gridDim.y * gridDim.z;
    unsigned sum, cnt, mine, sp = 0u;
    for (;;) {
        sum = 0u; cnt = 0u; mine = 0u;
#pragma unroll
        for (unsigned j = 0; j < 16; ++j) { const unsigned c = xb_ld(&bar[XB_XCNT(j)]); sum += c; cnt += (c > 0u) ? 1u : 0u; mine = (j == x) ? c : mine; }
        if (sum == G) break;
        __builtin_amdgcn_s_sleep(1);
        if ((++sp & 255u) == 0u) { if (xb_ld(&bar[XB_TMO])) break; if (sp > XB_SPIN_CAP) { atomicAdd(&bar[XB_TMO], 1u); break; } }
    }
    nloc = mine > 0u ? mine : 1u; nx = cnt > 0u ? cnt : 1u;
}
DI void xcd_barrier(const XcdBarrier& b) {
    asm volatile("s_waitcnt vmcnt(0)" ::: "memory");
    __syncthreads();
    if (threadIdx.x == 0) {
        unsigned* bar = b.bar;
        __builtin_amdgcn_s_waitcnt(0);
        unsigned nloc = b.st[0], nx = b.st[1];
        if (nloc == 0u) { xcd_barrier_complete(bar, b.x, nloc, nx); b.st[0] = nloc; b.st[1] = nx; }
        const unsigned old = xb_add(&bar[XB_XSUB(b.x)], 1u);
        const unsigned gen = old / nloc;
        if (old + 1u == (gen + 1u) * nloc) {
            __builtin_amdgcn_fence(__ATOMIC_RELEASE, "agent");
            asm volatile("s_waitcnt vmcnt(0)" ::: "memory");
            const unsigned og = xb_add(&bar[XB_TOP], 1u);
            const unsigned tg = og / nx;
            if (og + 1u == (tg + 1u) * nx) xb_add(&bar[XB_TOPGEN], 1u);
            else XB_SPIN(xb_ld(&bar[XB_TOPGEN]) == tg, bar);
            __builtin_amdgcn_fence(__ATOMIC_ACQUIRE, "agent");
            xb_add(&bar[XB_XGEN(b.x)], 1u);
            asm volatile("s_waitcnt vmcnt(0)" ::: "memory");
        } else {
            XB_SPIN(xb_ld(&bar[XB_XGEN(b.x)]) == gen, bar);
            __builtin_amdgcn_fence(__ATOMIC_ACQUIRE, "agent");
            asm volatile("s_waitcnt vmcnt(0)" ::: "memory");
        }
    }
    __syncthreads();
}

constexpr int S = 16384;
constexpr int NT = 512;
constexpr float EPS = 1e-6f;
constexpr size_t MiB = 1u << 20;
constexpr size_t W_IN = 0;
constexpr size_t W_GL = W_IN + (size_t)3072 * 1024 * 2;
constexpr size_t W_AOUT = W_IN + (size_t)3328 * 1024 * 2;
constexpr size_t W_FIN = W_AOUT + (size_t)1024 * 1024 * 2;
constexpr size_t W_FOUT = W_FIN + (size_t)2 * 5632 * 1024 * 2;
constexpr size_t W_DD = W_FOUT + (size_t)2 * 1024 * 2816 * 2;
constexpr size_t W_UP = W_DD + (size_t)768 * 1024 * 2;
constexpr size_t W_UQ = W_UP + (size_t)2048 * 256 * 2;
constexpr size_t W_BOUT = W_UQ + (size_t)1536 * 384 * 2;
constexpr size_t W_END = W_BOUT + (size_t)1024 * 1024 * 2;
static_assert(W_END <= 47 * MiB + 512 * 1024, "weights");
constexpr size_t MISC = 47 * MiB + 512 * 1024;
constexpr size_t MISC_BAR = MISC + 4096;
constexpr size_t PCNT = MISC + 32768;
constexpr size_t MISC_ZERO_BYTES = 32768 + 4 * 16384;
constexpr size_t XH = 48 * MiB;
constexpr size_t R = 80 * MiB;
constexpr size_t QK = R;
constexpr size_t VT = R + 32 * MiB;
constexpr size_t RB = R + 64 * MiB;
constexpr size_t GL = R + 96 * MiB;
constexpr size_t DEC = R + 97 * MiB;
constexpr size_t KVT = R + 98 * MiB;
constexpr size_t HB = R;
constexpr size_t CKV = R;
constexpr size_t CQ = R + 8 * MiB;
constexpr size_t KROPE = R + 20 * MiB;
constexpr size_t DBUF = R + 22 * MiB;
constexpr size_t QB = R + 22 * MiB;
constexpr size_t KB = R + 70 * MiB;
constexpr size_t VTM = R + 118 * MiB;
constexpr size_t ROPET = R + 162 * MiB;
constexpr size_t XSLOT = R + 164 * MiB;
constexpr size_t KRSS = XSLOT + 917504;
constexpr size_t WS_NEED = R + 165 * MiB;
static_assert(WS_NEED <= 256 * MiB, "ws");

constexpr int LDS_BYTES = 131072;

struct TJob { const float* src; const float* gain; bf16_t* dst; int ldn, col0, nvalid, nrows, K, mode; };
constexpr int NJOBS = 13;

struct Params {
    const float* x; const int* pos;
    const float *a_norm, *a_w_in, *a_w_gate_up, *a_b_gate, *a_out_norm, *a_w_out;
    const float *b_norm, *b_w_dq, *b_q_latent_norm, *b_w_uq, *b_q_norm, *b_w_out;
    const float *kv_norm, *kv_w_down, *kv_latent_norm, *kv_w_up, *k_norm;
    const float *f_norm, *f_w_in, *f_w_out;
    float* out; char* ws;
    TJob jobs[NJOBS];
    int jstart[NJOBS + 1];
    int ph_lo, ph_hi, pad0;
    float inv_freq[16];
};

DI void tr_load(const TJob& j, int t, float* tile, int tid) {
    const int ktn = j.K >> 6; const int rt = t / ktn, kt = t - rt * ktn; const int r0 = rt * 64, k0 = kt * 64;
    const int rl = tid & 63, kq = tid >> 6; const int r = r0 + rl; int sc; bool valid;
    if (j.mode == 0) { valid = r < j.nvalid; sc = j.col0 + r; }
    else if (j.mode == 2) { const int cl = r & 255, wcc = (cl >> 5) & 3; sc = ((r >> 8) * 2 + (wcc >> 1)) * 128 + (wcc & 1) * 64 + (cl >> 7) * 32 + (cl & 31); valid = true; }
    else { sc = ((r >> 7) & 1) * 2816 + (r >> 8) * 128 + (r & 127); valid = true; }
    float v[8];
#pragma unroll
    for (int kk = 0; kk < 8; ++kk) { const int k = k0 + kq * 8 + kk; v[kk] = 0.f; if (valid) { v[kk] = j.src[(size_t)k * j.ldn + sc]; if (j.gain) v[kk] *= j.gain[k]; } }
#pragma unroll
    for (int kk = 0; kk < 8; ++kk) tile[(kq * 8 + kk) * 65 + rl] = v[kk];
}
DI void tr_store(const TJob& j, int t, const float* tile, int tid) {
    const int ktn = j.K >> 6; const int rt = t / ktn, kt = t - rt * ktn; const int r0 = rt * 64, k0 = kt * 64;
    const int kl2 = tid & 31, rq = tid >> 5;
#pragma unroll
    for (int rr = 0; rr < 4; ++rr) { const int r = rq * 4 + rr; *(unsigned*)(j.dst + (size_t)(r0 + r) * j.K + k0 + 2 * kl2) = pack2(tile[(2 * kl2) * 65 + r], tile[(2 * kl2 + 1) * 65 + r]); }
}

DI void norm_phase(const float* x, bf16_t* out) {
    const int tidf = tid_fresh(); const int lane = tidf & 63; const int gw = (blockIdx.x * NT + tidf) >> 6, nw = (gridDim.x * NT) >> 6;
    for (int row = gw; row < S; row += nw) {
        const float* xp = x + (size_t)row * 1024 + lane * 4;
        f32x4 v[4]; float ss = 0.f;
#pragma unroll
        for (int i = 0; i < 4; ++i) { v[i] = *(const f32x4*)(xp + i * 256); ss += v[i][0] * v[i][0] + v[i][1] * v[i][1] + v[i][2] * v[i][2] + v[i][3] * v[i][3]; }
#pragma unroll
        for (int o = 32; o >= 1; o >>= 1) ss += __shfl_xor(ss, o);
        const float r = rsqrtf(ss * (1.f / 1024.f) + EPS);
        bf16_t* op = out + (size_t)row * 1024 + lane * 4;
#pragma unroll
        for (int i = 0; i < 4; ++i) { u32x2 w; w.x = pack2(nopack(v[i][0] * r), nopack(v[i][1] * r)); w.y = pack2(nopack(v[i][2] * r), nopack(v[i][3] * r)); *(u32x2*)(op + i * 256) = w; }
    }
}

namespace pg8 {
#define PG8_LAS __attribute__((address_space(3)))
constexpr int BM = 256, BK = 64, HALF = 128, HTB = HALF * BK * 2  , STAGE_BYTES = 8 * HTB, NXCD = 8, WGM = 8;

__host__ __device__ __forceinline__ int lds_byte(int r, int c) { const int st = (r >> 4) * 2 + (c >> 5), rr = r & 15, cc = c & 31, ob = rr * 64 + cc * 2; return st * 1024 + (ob ^ (((ob >> 9) & 1) << 5)); }
__host__ __device__ __forceinline__ void stage_rc(int b, int& R, int& C) { const int st = b / 1024, sb = b % 1024, swz = sb ^ (((sb >> 9) & 1) << 5); R = (st >> 1) * 16 + swz / 64; C = (st & 1) * 32 + (swz % 64) / 2; }
__host__ __device__ __forceinline__ int perm32(int rho) { const int n = rho >> 4, i = rho & 15; return 8 * (i >> 2) + 4 * n + (i & 3); }

struct Unit { int pm, pn; };
struct Gemm { const bf16_t* A; const bf16_t* Bt; int M, N, K; };

struct StaticOrder {
    int nM, nN, nwg, G, c;
    __host__ __device__ void init(int M, int N, int G_, int c_) { nM = M / BM; nN = N / BM; nwg = nM * nN; G = G_; c = c_; }
    __host__ __device__ bool next(int i, Unit& u) const {
        const long L = (long)i * G + c; if (L >= nwg) return false;
        int wgid = (int)L; { const int q = nwg / NXCD, r = nwg % NXCD, xcd = wgid % NXCD, off = wgid / NXCD; wgid = (xcd < r ? xcd * (q + 1) : r * (q + 1) + (xcd - r) * q) + off; }
        const int nig = WGM * nN, gid = wgid / nig, fm = gid * WGM, gsz = (nM - fm) < WGM ? (nM - fm) : WGM;
        u.pm = fm + ((wgid % nig) % gsz); u.pn = (wgid % nig) / gsz; return true;
    }
    __device__ __forceinline__ void a_ready(const Unit&) const {}
    __device__ __forceinline__ void done(const Unit&) const {}
};


template <class Epi, class Sched, bool ALIGN_EPI = false, bool SP2 = false>
__device__ __forceinline__ void gemm_phase(PG8_LAS unsigned char* lds, const Gemm g, const Sched& S, const Epi& E) {
    const int tid = tid_fresh(), wid = __builtin_amdgcn_readfirstlane(tid >> 6), lane = tid & 63, wr = wid >> 2, wc = wid & 3, fr = lane & 15, fq = lane >> 4;
    const int K = g.K, nt = K / BK;
    unsigned voffA[2], voffB[2];
#pragma unroll
    for (int i = 0; i < 2; ++i) { int R, C; stage_rc(tid * 16 + i * 8192, R, C); const int Rb = Epi::PERM ? ((R & ~31) + perm32(R & 31)) : R;
        voffA[i] = (unsigned)(R * K + C) * 2u; voffB[i] = (unsigned)(Rb * K + C) * 2u; }
    const size_t kstep = (size_t)(BK * 2);
    const size_t hstep = (size_t)HALF * K * 2;
    const size_t tstep = 2 * hstep;
    const unsigned ldsw = (unsigned)wid * 1024u;
    const int aoff = lds_byte(wr * 64 + fr, fq * 8), boff = lds_byte(wc * 32 + fr, fq * 8);
#define PG8_SA(b, h) (((b) * 2 + (h)) * HTB)
#define PG8_SB(b, h) ((4 + (b) * 2 + (h)) * HTB)
#define PG8_STAGE(bufoff, gbase, voff) do { _Pragma("unroll") for (int _i = 0; _i < 2; ++_i) \
        __builtin_amdgcn_global_load_lds((const unsigned*)((const char*)(gbase) + (voff)[_i]), (PG8_LAS unsigned*)(lds + (bufoff) + ldsw + _i * 8192), 16, 0, 0); } while (0)
#define PG8_LDA(dst, b, h) do { _Pragma("unroll") for (int m = 0; m < 4; ++m) _Pragma("unroll") for (int k = 0; k < 2; ++k) dst[m][k] = *(const PG8_LAS bf16x8*)(lds + PG8_SA(b, h) + aoff + m * 2048 + k * 1024); } while (0)
#define PG8_LDB(dst, b, h) do { _Pragma("unroll") for (int n = 0; n < 2; ++n) _Pragma("unroll") for (int k = 0; k < 2; ++k) dst[n][k] = *(const PG8_LAS bf16x8*)(lds + PG8_SB(b, h) + boff + n * 2048 + k * 1024); } while (0)
#define PG8_MMA(ai, bj, At, Bt) do { __builtin_amdgcn_s_setprio(1); _Pragma("unroll") for (int m = 0; m < 4; ++m) _Pragma("unroll") for (int n = 0; n < 2; ++n) _Pragma("unroll") for (int k = 0; k < 2; ++k) \
        acc[ai][bj][m][n] = __builtin_amdgcn_mfma_f32_16x16x32_bf16(Bt[n][k], At[m][k], acc[ai][bj][m][n], 0, 0, 0); __builtin_amdgcn_s_setprio(0); } while (0)
#define PG8_WAIT_V(n) asm volatile("s_waitcnt vmcnt(" #n ")" ::: "memory")
#define PG8_WAIT_L(n) asm volatile("s_waitcnt lgkmcnt(" #n ")" ::: "memory")
#define PG8_BAR __builtin_amdgcn_s_barrier()
#define PG8_SCHED __builtin_amdgcn_sched_barrier(0)
    Unit cur, nxt; int ui = 0;
    if (!S.next(0, cur)) return;
    f32x4 acc[2][2][4][2];
#pragma unroll
    for (int a = 0; a < 2; ++a)
#pragma unroll
        for (int b = 0; b < 2; ++b)
#pragma unroll
            for (int m = 0; m < 4; ++m)
#pragma unroll
                for (int n = 0; n < 2; ++n) acc[a][b][m][n] = (f32x4){0.f, 0.f, 0.f, 0.f};
    bf16x8 At[4][2], B0[2][2], B1[2][2];
    const char* cA = (const char*)g.A + (size_t)cur.pm * tstep; const char* cB = (const char*)g.Bt + (size_t)cur.pn * tstep;
    S.a_ready(cur);
    if constexpr (SP2) {
        PG8_STAGE(PG8_SB(0, 0), cB, voffB); PG8_STAGE(PG8_SB(0, 1), cB + hstep, voffB); PG8_STAGE(PG8_SA(0, 0), cA, voffA); PG8_STAGE(PG8_SA(0, 1), cA + hstep, voffA);
        if (wr == 1) PG8_BAR;
        PG8_WAIT_V(2); PG8_BAR;
        PG8_STAGE(PG8_SB(1, 0), cB + kstep, voffB); PG8_STAGE(PG8_SA(1, 0), cA + kstep, voffA); PG8_STAGE(PG8_SB(1, 1), cB + hstep + kstep, voffB);
        PG8_WAIT_V(6); PG8_BAR;
    } else {
        PG8_STAGE(PG8_SB(0, 0), cB, voffB); PG8_STAGE(PG8_SA(0, 0), cA, voffA); PG8_STAGE(PG8_SB(0, 1), cB + hstep, voffB); PG8_STAGE(PG8_SA(0, 1), cA + hstep, voffA);
        if (wr == 1) PG8_BAR;
        PG8_WAIT_V(4); PG8_BAR;
        PG8_STAGE(PG8_SB(1, 0), cB + kstep, voffB); PG8_STAGE(PG8_SA(1, 0), cA + kstep, voffA); PG8_STAGE(PG8_SB(1, 1), cB + hstep + kstep, voffB);
        PG8_WAIT_V(6); PG8_BAR;
    }
    for (;;) {
        const bool has_next = S.next(ui + 1, nxt);
        const char* nA = has_next ? (const char*)g.A + (size_t)nxt.pm * tstep : cA; const char* nB = has_next ? (const char*)g.Bt + (size_t)nxt.pn * tstep : cB;
        for (int t = 0; t < nt; t += 2) {
            const bool last = (t == nt - 2);
            const char* a1 = cA + (size_t)(t + 1) * kstep;
            const char* a2 = last ? nA : cA + (size_t)(t + 2) * kstep; const char* b2 = last ? nB : cB + (size_t)(t + 2) * kstep;
            const char* a3 = a2 + kstep; const char* b3 = b2 + kstep;
            if (last && has_next) S.a_ready(nxt);
            if constexpr (SP2) {
            PG8_LDB(B0, 0, 0); PG8_LDB(B1, 0, 1); PG8_SCHED; PG8_LDA(At, 0, 0); PG8_STAGE(PG8_SA(1, 1), a1 + hstep, voffA);
            PG8_WAIT_V(8); PG8_WAIT_L(0); PG8_BAR; PG8_MMA(0, 0, At, B0); PG8_MMA(0, 1, At, B1); PG8_BAR; PG8_SCHED;
            PG8_LDA(At, 0, 1); PG8_STAGE(PG8_SB(0, 0), b2, voffB); PG8_STAGE(PG8_SB(0, 1), b2 + hstep, voffB); PG8_STAGE(PG8_SA(0, 0), a2, voffA);
            PG8_WAIT_V(8); PG8_WAIT_L(0); PG8_BAR; PG8_MMA(1, 0, At, B0); PG8_MMA(1, 1, At, B1); PG8_BAR; PG8_SCHED;
            PG8_LDB(B0, 1, 0); PG8_LDB(B1, 1, 1); PG8_SCHED; PG8_LDA(At, 1, 0); PG8_STAGE(PG8_SA(0, 1), a2 + hstep, voffA);
            PG8_WAIT_V(8); PG8_WAIT_L(0); PG8_BAR; PG8_MMA(0, 0, At, B0); PG8_MMA(0, 1, At, B1); PG8_BAR; PG8_SCHED;
            PG8_LDA(At, 1, 1); PG8_STAGE(PG8_SB(1, 0), b3, voffB); PG8_STAGE(PG8_SB(1, 1), b3 + hstep, voffB); PG8_STAGE(PG8_SA(1, 0), a3, voffA);
            PG8_WAIT_V(8); PG8_WAIT_L(0); PG8_BAR; PG8_MMA(1, 0, At, B0); PG8_MMA(1, 1, At, B1); PG8_BAR; PG8_SCHED;
            } else {
            PG8_LDB(B0, 0, 0); PG8_SCHED; PG8_LDA(At, 0, 0); PG8_STAGE(PG8_SA(1, 1), a1 + hstep, voffA);
            PG8_WAIT_L(8); PG8_BAR; PG8_WAIT_L(0); PG8_MMA(0, 0, At, B0); PG8_BAR; PG8_SCHED;
            PG8_LDB(B1, 0, 1); PG8_STAGE(PG8_SB(0, 0), b2, voffB);
            PG8_BAR; PG8_WAIT_L(0); PG8_MMA(0, 1, At, B1); PG8_BAR;
            PG8_LDA(At, 0, 1); PG8_STAGE(PG8_SA(0, 0), a2, voffA);
            PG8_BAR; PG8_WAIT_L(0); PG8_MMA(1, 0, At, B0); PG8_BAR; PG8_SCHED;
            PG8_STAGE(PG8_SB(0, 1), b2 + hstep, voffB);
            PG8_WAIT_V(6); PG8_BAR; PG8_MMA(1, 1, At, B1); PG8_BAR;
            PG8_LDB(B0, 1, 0); PG8_SCHED; PG8_LDA(At, 1, 0); PG8_STAGE(PG8_SA(0, 1), a2 + hstep, voffA);
            PG8_WAIT_L(8); PG8_BAR; PG8_WAIT_L(0); PG8_MMA(0, 0, At, B0); PG8_BAR; PG8_SCHED;
            PG8_LDB(B1, 1, 1); PG8_STAGE(PG8_SB(1, 0), b3, voffB);
            PG8_BAR; PG8_WAIT_L(0); PG8_MMA(0, 1, At, B1); PG8_BAR;
            PG8_LDA(At, 1, 1); PG8_STAGE(PG8_SA(1, 0), a3, voffA);
            PG8_BAR; PG8_WAIT_L(0); PG8_MMA(1, 0, At, B0); PG8_BAR; PG8_SCHED;
            PG8_STAGE(PG8_SB(1, 1), b3 + hstep, voffB);
            PG8_WAIT_V(6); PG8_BAR; PG8_MMA(1, 1, At, B1); PG8_BAR;
            }
        }
        if constexpr (ALIGN_EPI) { if (wr == 0) PG8_BAR; }
        if constexpr (!Epi::AFTER_DRAIN) { E(acc, cur, wr, wc, fr, fq); S.done(cur); }
        if (!has_next) break;
#pragma unroll
        for (int a = 0; a < 2; ++a)
#pragma unroll
            for (int b = 0; b < 2; ++b)
#pragma unroll
                for (int m = 0; m < 4; ++m)
#pragma unroll
                    for (int n = 0; n < 2; ++n) acc[a][b][m][n] = (f32x4){0.f, 0.f, 0.f, 0.f};
        cur = nxt; cA = nA; cB = nB; ++ui;
        if constexpr (ALIGN_EPI) { if (wr == 1) PG8_BAR; }
    }
    PG8_WAIT_V(0);
    if constexpr (!ALIGN_EPI) { if (wr == 0) PG8_BAR; }
    PG8_BAR;
    if constexpr (Epi::AFTER_DRAIN) { E.fused(acc, cur, wr, wc, fr, fq, lds, wid, lane); S.done(cur); }
#undef PG8_SA
#undef PG8_SB
#undef PG8_STAGE
#undef PG8_LDA
#undef PG8_LDB
#undef PG8_MMA
#undef PG8_WAIT_V
#undef PG8_WAIT_L
#undef PG8_BAR
#undef PG8_SCHED
}
}

enum { EPI_INPROJ = 0, EPI_RES = 1, EPI_SWIGLU = 2, EPI_F32 = 3, EPI_KV = 4, EPI_BF16 = 5 };
template <int MODE> struct Epi {
    static constexpr bool PERM = (MODE != EPI_RES && MODE != EPI_F32), AFTER_DRAIN = false;
    const float* res; float* outf; int ldo; bf16_t* o0; bf16_t* o1; bf16_t* o2;
    DI void operator()(const f32x4 (&acc)[2][2][4][2], const pg8::Unit& u, int wr, int wc, int fr, int fq) const {
#pragma unroll
        for (int ai = 0; ai < 2; ++ai)
#pragma unroll
            for (int m = 0; m < 4; ++m) {
                const int r = u.pm * 256 + ai * 128 + wr * 64 + m * 16 + fr;
                if (MODE == EPI_SWIGLU) {
                    const f32x4 g0 = acc[ai][0][m][0], g1 = acc[ai][0][m][1], u0 = acc[ai][1][m][0], u1 = acc[ai][1][m][1];
#define SWG(g, u) nopack(nopack(siluf(nopack(g))) * (u))
                    u32x4 w; w.x = pack2(SWG(g0[0], u0[0]), SWG(g0[1], u0[1])); w.y = pack2(SWG(g0[2], u0[2]), SWG(g0[3], u0[3]));
                    w.z = pack2(SWG(g1[0], u1[0]), SWG(g1[1], u1[1])); w.w = pack2(SWG(g1[2], u1[2]), SWG(g1[3], u1[3]));
#undef SWG
                    *(u32x4*)(o0 + (size_t)r * 2816 + u.pn * 128 + wc * 32 + fq * 8) = w;
                } else {
#pragma unroll
                    for (int bj = 0; bj < 2; ++bj) {
                        if (!PERM) {
#pragma unroll
                            for (int n = 0; n < 2; ++n) {
                                const int c = u.pn * 256 + bj * 128 + wc * 32 + n * 16 + fq * 4; const f32x4 a = acc[ai][bj][m][n];
                                if (MODE == EPI_RES) { const size_t off = (size_t)r * 1024 + c; const f32x4 rv = *(const f32x4*)(res + off); f32x4 o; o[0] = nopack(rv[0] + a[0]); o[1] = nopack(rv[1] + a[1]); o[2] = nopack(rv[2] + a[2]); o[3] = nopack(rv[3] + a[3]); *(f32x4*)(outf + off) = o; }
                                else { *(f32x4*)(outf + (size_t)r * ldo + c) = a; }
                            }
                        } else {
                            const int cl = bj * 128 + wc * 32 + fq * 8; const int c = u.pn * 256 + cl; const f32x4 a0 = acc[ai][bj][m][0], a1 = acc[ai][bj][m][1];
                            if (MODE == EPI_INPROJ) {
                                if (u.pn < 4) { u32x4 w; w.x = pack2(a0[0], a0[1]); w.y = pack2(a0[2], a0[3]); w.z = pack2(a1[0], a1[1]); w.w = pack2(a1[2], a1[3]); *(u32x4*)(o0 + (size_t)r * 1024 + c) = w; }
                                else if (u.pn < 8) { const int h = u.pn - 4, ch = r >> 6, jx = r & 63; bf16_t* vp = o1 + ((size_t)(ch * 4 + h) * 256 + cl) * 64 + jx;
#pragma unroll
                                    for (int e = 0; e < 4; ++e) { vp[e * 64] = f2bf(a0[e]); vp[(e + 4) * 64] = f2bf(a1[e]); } }
                                else { u32x4 w; w.x = pack2(nopack(siluf(nopack(a0[0]))), nopack(siluf(nopack(a0[1])))); w.y = pack2(nopack(siluf(nopack(a0[2]))), nopack(siluf(nopack(a0[3])))); w.z = pack2(nopack(siluf(nopack(a1[0]))), nopack(siluf(nopack(a1[1])))); w.w = pack2(nopack(siluf(nopack(a1[2]))), nopack(siluf(nopack(a1[3]))));
                                    *(u32x4*)(o2 + (size_t)r * 1024 + (c - 2048)) = w; }
                            } else if (MODE == EPI_KV) {
                                const int head = u.pn * 2 + bj, hc = wc * 32 + fq * 8;
                                if (wc < 2) { u32x4 w; w.x = pack2(a0[0], a0[1]); w.y = pack2(a0[2], a0[3]); w.z = pack2(a1[0], a1[1]); w.w = pack2(a1[2], a1[3]); *(u32x4*)(o0 + ((size_t)r * 16 + head) * 96 + hc) = w; }
                                else { bf16_t* vp = o1 + ((size_t)head * 64 + (hc - 64)) * S + r;
#pragma unroll
                                    for (int e = 0; e < 4; ++e) { vp[(size_t)e * S] = f2bf(a0[e]); vp[(size_t)(e + 4) * S] = f2bf(a1[e]); } }
                            } else {
                                u32x4 w; w.x = pack2(a0[0], a0[1]); w.y = pack2(a0[2], a0[3]); w.z = pack2(a1[0], a1[1]); w.w = pack2(a1[2], a1[3]); *(u32x4*)(o0 + (size_t)r * ldo + c) = w;
                            }
                        }
                    }
                }
                asm volatile("" ::: "memory");
            }
    }
};
template <int MODE>
DI void gemm_phase(const bf16_t* A, const bf16_t* Bt, int N, int K, const Epi<MODE>& E, char* smem) {
    asm volatile("" : "+s"(K));
    pg8::Gemm g{A, Bt, S, N, K}; pg8::StaticOrder so; so.init(S, N, (int)gridDim.x, (int)blockIdx.x);
    pg8::gemm_phase<Epi<MODE>, pg8::StaticOrder, true, true>((PG8_LAS unsigned char*)smem, g, so, E);
}

struct EpiResNorm {
    static constexpr bool PERM = false, AFTER_DRAIN = true;
    const float* res; float* outf; bf16_t* xh; float* xbuf; unsigned* cnt;
    DI void operator()(const f32x4 (&)[2][2][4][2], const pg8::Unit&, int, int, int, int) const {}
    DI void fused(f32x4 (&acc)[2][2][4][2], const pg8::Unit& u, int wr, int wc, int fr, int fq, PG8_LAS unsigned char* lds, int wid, int lane) const {
        PG8_LAS float* P = (PG8_LAS float*)lds; PG8_LAS float* Sr = (PG8_LAS float*)(lds + 4096);
        const int tid = wid * 64 + lane;
#pragma unroll
        for (int ai = 0; ai < 2; ++ai)
#pragma unroll
            for (int m = 0; m < 4; ++m) {
                const int rl = ai * 128 + wr * 64 + m * 16 + fr; const size_t rowoff = (size_t)(u.pm * 256 + rl) * 1024 + u.pn * 256 + wc * 32 + fq * 4; float ss = 0.f;
#pragma unroll
                for (int bj = 0; bj < 2; ++bj)
#pragma unroll
                    for (int n = 0; n < 2; ++n) { const f32x4 rv = *(const f32x4*)(res + rowoff + bj * 128 + n * 16), a = acc[ai][bj][m][n]; f32x4 v; v[0] = nopack(rv[0] + a[0]); v[1] = nopack(rv[1] + a[1]); v[2] = nopack(rv[2] + a[2]); v[3] = nopack(rv[3] + a[3]);
                        acc[ai][bj][m][n] = v; ss = __builtin_fmaf(v[0], v[0], ss); ss = nopack(__builtin_fmaf(v[1], v[1], ss)); ss = __builtin_fmaf(v[2], v[2], ss); ss = nopack(__builtin_fmaf(v[3], v[3], ss)); }
                ss += __shfl_xor(ss, 16); ss += __shfl_xor(ss, 32);
                if (fq == 0) P[rl * 4 + wc] = ss;
                asm volatile("" ::: "memory");
            }
        __syncthreads();
        if (tid < 256) {
            const float tot = (P[tid * 4] + P[tid * 4 + 1]) + (P[tid * 4 + 2] + P[tid * 4 + 3]);
            __hip_atomic_store(xbuf + (size_t)(u.pm * 256 + tid) * 4 + u.pn, tot, __ATOMIC_RELAXED, __HIP_MEMORY_SCOPE_AGENT);
            asm volatile("s_waitcnt vmcnt(0)" ::: "memory");
            if (lane == 0) __hip_atomic_fetch_add(cnt + 64 * u.pm, 1u, __ATOMIC_RELAXED, __HIP_MEMORY_SCOPE_AGENT);
        }
        if (wid == 0) {
            unsigned sp = 0u;
            while (__hip_atomic_load(cnt + 64 * u.pm, __ATOMIC_RELAXED, __HIP_MEMORY_SCOPE_AGENT) < 16u) { __builtin_amdgcn_s_sleep(1); if (++sp > (1u << 22)) break; }
            __builtin_amdgcn_fence(__ATOMIC_ACQUIRE, "agent");
            asm volatile("s_waitcnt vmcnt(0)" ::: "memory");
        }
        __syncthreads();
        if (tid < 256) {
            const float* sl = xbuf + (size_t)(u.pm * 256 + tid) * 4;
            const float t = (__hip_atomic_load(sl, __ATOMIC_RELAXED, __HIP_MEMORY_SCOPE_AGENT) + __hip_atomic_load(sl + 1, __ATOMIC_RELAXED, __HIP_MEMORY_SCOPE_AGENT))
                          + (__hip_atomic_load(sl + 2, __ATOMIC_RELAXED, __HIP_MEMORY_SCOPE_AGENT) + __hip_atomic_load(sl + 3, __ATOMIC_RELAXED, __HIP_MEMORY_SCOPE_AGENT));
            Sr[tid] = rsqrtf(t * (1.f / 1024.f) + EPS);
        }
        __syncthreads();
#pragma unroll
        for (int ai = 0; ai < 2; ++ai)
#pragma unroll
            for (int m = 0; m < 4; ++m) {
                const int rl = ai * 128 + wr * 64 + m * 16 + fr; const size_t rowoff = (size_t)(u.pm * 256 + rl) * 1024 + u.pn * 256 + wc * 32 + fq * 4; const float rstd = Sr[rl];
#pragma unroll
                for (int bj = 0; bj < 2; ++bj)
#pragma unroll
                    for (int n = 0; n < 2; ++n) { const f32x4 v = acc[ai][bj][m][n]; const size_t off = rowoff + bj * 128 + n * 16; *(f32x4*)(outf + off) = v;
                        u32x2 w; w.x = pack2(nopack(v[0] * rstd), nopack(v[1] * rstd)); w.y = pack2(nopack(v[2] * rstd), nopack(v[3] * rstd)); *(u32x2*)(xh + off) = w; }
                asm volatile("" ::: "memory");
            }
    }
};
struct EpiLatent {
    static constexpr bool PERM = false, AFTER_DRAIN = true;
    bf16_t* ckv; bf16_t* cq; float* krope; float* xbuf; unsigned* cnt; const float* ropet; const float* kgain; float* krss;
    DI void operator()(const f32x4 (&)[2][2][4][2], const pg8::Unit&, int, int, int, int) const {}
    DI void fused(f32x4 (&acc)[2][2][4][2], const pg8::Unit& u, int wr, int wc, int fr, int fq, PG8_LAS unsigned char* lds, int wid, int lane) const {
        PG8_LAS float* P = (PG8_LAS float*)lds; PG8_LAS float* Sr = (PG8_LAS float*)(lds + 4096);
        const int tid = wid * 64 + lane;
#pragma unroll
        for (int ai = 0; ai < 2; ++ai)
#pragma unroll
            for (int m = 0; m < 4; ++m) {
                const int rl = ai * 128 + wr * 64 + m * 16 + fr; float ss = 0.f;
#pragma unroll
                for (int bj = 0; bj < 2; ++bj)
#pragma unroll
                    for (int n = 0; n < 2; ++n) { const f32x4 v = acc[ai][bj][m][n]; const float q = v[0] * v[0] + v[1] * v[1] + v[2] * v[2] + v[3] * v[3]; if (bj == 0 || u.pn != 2) ss += q; }
                ss += __shfl_xor(ss, 16); ss += __shfl_xor(ss, 32);
                if (fq == 0) P[rl * 4 + wc] = ss;
            }
        __syncthreads();
        if (u.pn != 0) {
            if (tid < 256) {
                const float tot = (P[tid * 4] + P[tid * 4 + 1]) + (P[tid * 4 + 2] + P[tid * 4 + 3]);
                __hip_atomic_store(xbuf + (size_t)(u.pm * 256 + tid) * 2 + (u.pn - 1), tot, __ATOMIC_RELAXED, __HIP_MEMORY_SCOPE_AGENT);
                asm volatile("s_waitcnt vmcnt(0)" ::: "memory");
                if (lane == 0) __hip_atomic_fetch_add(cnt + 64 * u.pm, 1u, __ATOMIC_RELAXED, __HIP_MEMORY_SCOPE_AGENT);
            }
            if (wid == 0) {
                unsigned sp = 0u;
                while (__hip_atomic_load(cnt + 64 * u.pm, __ATOMIC_RELAXED, __HIP_MEMORY_SCOPE_AGENT) < 8u) { __builtin_amdgcn_s_sleep(1); if (++sp > (1u << 22)) break; }
                __builtin_amdgcn_fence(__ATOMIC_ACQUIRE, "agent");
                asm volatile("s_waitcnt vmcnt(0)" ::: "memory");
            }
            __syncthreads();
            if (tid < 256) {
                const float* sl = xbuf + (size_t)(u.pm * 256 + tid) * 2;
                const float t = __hip_atomic_load(sl, __ATOMIC_RELAXED, __HIP_MEMORY_SCOPE_AGENT) + __hip_atomic_load(sl + 1, __ATOMIC_RELAXED, __HIP_MEMORY_SCOPE_AGENT);
                Sr[tid] = rsqrtf(t * (1.f / 384.f) + EPS);
            }
        } else {
            if (tid < 256) Sr[tid] = rsqrtf(((P[tid * 4] + P[tid * 4 + 1]) + (P[tid * 4 + 2] + P[tid * 4 + 3])) * (1.f / 256.f) + EPS);
        }
        __syncthreads();
#pragma unroll
        for (int ai = 0; ai < 2; ++ai)
#pragma unroll
            for (int m = 0; m < 4; ++m) {
                const int rl = ai * 128 + wr * 64 + m * 16 + fr; const size_t r = (size_t)(u.pm * 256 + rl); const float rstd = Sr[rl];
#pragma unroll
                for (int bj = 0; bj < 2; ++bj)
#pragma unroll
                    for (int n = 0; n < 2; ++n) {
                        const f32x4 v = acc[ai][bj][m][n]; const int cl = bj * 128 + wc * 32 + n * 16 + fq * 4;
                        u32x2 w; w.x = pack2(v[0] * rstd, v[1] * rstd); w.y = pack2(v[2] * rstd, v[3] * rstd);
                        if (u.pn == 0) *(u32x2*)(ckv + r * 256 + cl) = w;
                        else if (u.pn == 1) *(u32x2*)(cq + r * 384 + cl) = w;
                        else if (bj == 0) *(u32x2*)(cq + r * 384 + 256 + cl) = w;
                    }
                if (u.pn == 2 && wc == 0) {
                    const f32x4 v0 = acc[ai][1][m][0], v1 = acc[ai][1][m][1];
                    float q = (v0[0] * v0[0] + v0[1] * v0[1] + v0[2] * v0[2] + v0[3] * v0[3]) + (v1[0] * v1[0] + v1[1] * v1[1] + v1[2] * v1[2] + v1[3] * v1[3]);
                    q += __shfl_xor(q, 16); q += __shfl_xor(q, 32);
                    if (fq == 0) krss[r] = q;
                    const f32x4 g1 = *(const f32x4*)(kgain + 64 + 4 * fq), g2 = *(const f32x4*)(kgain + 80 + 4 * fq);
                    const f32x4 cs = *(const f32x4*)(ropet + r * 32 + 4 * fq), sn = *(const f32x4*)(ropet + r * 32 + 16 + 4 * fq);
                    const f32x4 x1 = v0 * g1, x2 = v1 * g2;
                    *(f32x4*)(krope + r * 32 + 4 * fq) = x1 * cs - x2 * sn; *(f32x4*)(krope + r * 32 + 16 + 4 * fq) = x1 * sn + x2 * cs;
                }
                asm volatile("" ::: "memory");
            }
    }
};
DI void gemm_phase_latent(const bf16_t* A, const bf16_t* Bt, const EpiLatent& E, char* smem) {
    int K = 1024; asm volatile("" : "+s"(K));
    pg8::Gemm g{A, Bt, S, 768, K}; pg8::StaticOrder so; so.init(S, 768, (int)gridDim.x, (int)blockIdx.x);
    pg8::gemm_phase<EpiLatent, pg8::StaticOrder, false, true>((PG8_LAS unsigned char*)smem, g, so, E);
}
struct EpiKV2 {
    static constexpr bool PERM = true, AFTER_DRAIN = false;
    bf16_t* kb; bf16_t* vt; const float* krss; const float* krope;
    DI void operator()(const f32x4 (&acc)[2][2][4][2], const pg8::Unit& u, int wr, int wc, int fr, int fq) const {
        const int head = u.pn * 2 + (wc >> 1);
#pragma unroll
        for (int ai = 0; ai < 2; ++ai)
#pragma unroll
            for (int m = 0; m < 4; ++m) {
                const int r = u.pm * 256 + ai * 128 + wr * 64 + m * 16 + fr;
                if ((wc & 1) == 0) {
                    float ss = 0.f;
#pragma unroll
                    for (int bj = 0; bj < 2; ++bj)
#pragma unroll
                        for (int n = 0; n < 2; ++n) { const f32x4 v = acc[ai][bj][m][n]; ss += v[0] * v[0] + v[1] * v[1] + v[2] * v[2] + v[3] * v[3]; }
                    ss += __shfl_xor(ss, 16); ss += __shfl_xor(ss, 32);
                    const float rstd = rsqrtf((ss + krss[r]) * (1.f / 96.f) + EPS);
                    bf16_t* kp = kb + ((size_t)r * 16 + head) * 96;
#pragma unroll
                    for (int bj = 0; bj < 2; ++bj) { const f32x4 a0 = acc[ai][bj][m][0], a1 = acc[ai][bj][m][1];
                        u32x4 w; w.x = pack2(nopack(a0[0] * rstd), nopack(a0[1] * rstd)); w.y = pack2(nopack(a0[2] * rstd), nopack(a0[3] * rstd)); w.z = pack2(nopack(a1[0] * rstd), nopack(a1[1] * rstd)); w.w = pack2(nopack(a1[2] * rstd), nopack(a1[3] * rstd)); *(u32x4*)(kp + bj * 32 + fq * 8) = w; }
                    const f32x4 k0 = *(const f32x4*)(krope + (size_t)r * 32 + fq * 8) * rstd, k1 = *(const f32x4*)(krope + (size_t)r * 32 + fq * 8 + 4) * rstd;
                    u32x4 w; w.x = pack2(k0[0], k0[1]); w.y = pack2(k0[2], k0[3]); w.z = pack2(k1[0], k1[1]); w.w = pack2(k1[2], k1[3]); *(u32x4*)(kp + 64 + fq * 8) = w;
                } else {
#pragma unroll
                    for (int bj = 0; bj < 2; ++bj) { const f32x4 a0 = acc[ai][bj][m][0], a1 = acc[ai][bj][m][1]; bf16_t* vp = vt + ((size_t)head * 64 + bj * 32 + fq * 8) * S + r;
#pragma unroll
                        for (int e = 0; e < 4; ++e) { vp[(size_t)e * S] = f2bf(a0[e]); vp[(size_t)(e + 4) * S] = f2bf(a1[e]); } }
                }
                asm volatile("" ::: "memory");
            }
    }
};
DI void gemm_phase_kv2(const bf16_t* A, const bf16_t* Bt, const EpiKV2& E, char* smem) {
    int K = 256; asm volatile("" : "+s"(K));
    pg8::Gemm g{A, Bt, S, 2048, K}; pg8::StaticOrder so; so.init(S, 2048, (int)gridDim.x, (int)blockIdx.x);
    pg8::gemm_phase<EpiKV2, pg8::StaticOrder, true, true>((PG8_LAS unsigned char*)smem, g, so, E);
}
DI void gemm_phase_resnorm(const bf16_t* A, const bf16_t* Bt, int K, const EpiResNorm& E, char* smem) {
    asm volatile("" : "+s"(K));
    pg8::Gemm g{A, Bt, S, 1024, K}; pg8::StaticOrder so; so.init(S, 1024, (int)gridDim.x, (int)blockIdx.x);
    pg8::gemm_phase<EpiResNorm, pg8::StaticOrder, false, true>((PG8_LAS unsigned char*)smem, g, so, E);
}

DI void gla_gate(const Params& p, int n, int h, float* gl_s, float* tot_s, float (&bcum)[32], float& blast) {
    const int tid = tid_fresh() & 255, c = tid & 127, hf = tid >> 7;
    const float* glp = (const float*)(p.ws + GL) + (size_t)n * 64 * 16;
    *(f32x4*)(gl_s + tid * 4) = *(const f32x4*)(glp + tid * 4);
    float wgu[16];
#pragma unroll
    for (int r = 0; r < 16; ++r) wgu[r] = p.a_w_gate_up[r * 512 + h * 128 + c];
    const float bias = p.a_b_gate[h * 128 + c];
    __syncthreads();
    float cum = 0.f;
#pragma unroll
    for (int i = 0; i < 32; ++i) {
        const f32x4* gr = (const f32x4*)(gl_s + (hf * 32 + i) * 16); float z = bias;
#pragma unroll
        for (int r4 = 0; r4 < 4; ++r4) { const f32x4 g = gr[r4];
#pragma unroll
            for (int e = 0; e < 4; ++e) { z = __builtin_fmaf(g[e], wgu[r4 * 4 + e], z); asm("" : "+v"(z)); } }
        const float ls = fminf(z, 0.f) - __logf(1.f + __expf(-fabsf(z)));
        cum += ls * (1.f / 16.f); bcum[i] = cum;
    }
    tot_s[hf * 128 + c] = cum;
    __syncthreads();
    const float t0 = tot_s[c], t1 = tot_s[128 + c];
    if (hf) {
#pragma unroll
        for (int i = 0; i < 32; ++i) bcum[i] += t0;
    }
    blast = t0 + t1;
}

DI void gla_kv_unit(const Params& p, int u, char* smem) {
    float* gl_s = (float*)smem; float* tot_s = gl_s + 1024; bf16_t* kend_s = (bf16_t*)(tot_s + 256);
    const int tid = tid_fresh() & 255, c = tid & 127, hf = tid >> 7, lane = tid & 63, w = tid >> 6, lr = lane & 15, lq = lane >> 4;
    const int n = u >> 2, h = u & 3;
    float bcum[32], blast; gla_gate(p, n, h, gl_s, tot_s, bcum, blast);
    const bf16_t* kp = (const bf16_t*)(p.ws + QK) + (size_t)(n * 64 + hf * 32) * 1024 + 512 + h * 128 + c;
    unsigned pk[16];
#pragma unroll
    for (int i = 0; i < 32; i += 2) {
        const float k0 = bf2f(kp[(size_t)i * 1024]), k1 = bf2f(kp[(size_t)(i + 1) * 1024]);
        pk[i >> 1] = pack2(k0 * __expf(blast - bcum[i]), k1 * __expf(blast - bcum[i + 1]));
    }
    u32x4* dst = (u32x4*)(kend_s + c * 72 + hf * 32);
#pragma unroll
    for (int i = 0; i < 4; ++i) dst[i] = (u32x4){pk[4 * i], pk[4 * i + 1], pk[4 * i + 2], pk[4 * i + 3]};
    if (hf == 0) ((float*)(p.ws + DEC))[(size_t)u * 128 + c] = __expf(blast);
    __syncthreads();
    const int dv0 = w * 64;
    const bf16_t* vt = (const bf16_t*)(p.ws + VT) + ((size_t)u * 256 + dv0) * 64;
    bf16x8 vf[4][2];
#pragma unroll
    for (int mt = 0; mt < 4; ++mt)
#pragma unroll
        for (int kk = 0; kk < 2; ++kk) vf[mt][kk] = *(const bf16x8*)(vt + (mt * 16 + lr) * 64 + kk * 32 + lq * 8);
    bf16_t* kvo = (bf16_t*)(p.ws + KVT) + (size_t)u * 256 * 128;
#pragma unroll
    for (int half = 0; half < 2; ++half) {
        f32x4 acc[4][4];
#pragma unroll
        for (int a = 0; a < 4; ++a)
#pragma unroll
            for (int b = 0; b < 4; ++b) acc[a][b] = (f32x4){0.f, 0.f, 0.f, 0.f};
#pragma unroll
        for (int kk = 0; kk < 2; ++kk)
#pragma unroll
            for (int nt = 0; nt < 4; ++nt) {
                const bf16x8 kf = *(const bf16x8*)(kend_s + ((half * 4 + nt) * 16 + lr) * 72 + kk * 32 + lq * 8);
#pragma unroll
                for (int mt = 0; mt < 4; ++mt) acc[nt][mt] = mfma16(kf, vf[mt][kk], acc[nt][mt]);
            }
#pragma unroll
        for (int nt = 0; nt < 4; ++nt)
#pragma unroll
            for (int mt = 0; mt < 4; ++mt) {
                const int dk = (half * 4 + nt) * 16 + lq * 4, dv = dv0 + mt * 16 + lr; const f32x4 a = acc[nt][mt];
                u32x2 wv; wv.x = pack2(a[0], a[1]); wv.y = pack2(a[2], a[3]); *(u32x2*)(kvo + (size_t)dv * 128 + dk) = wv;
            }
    }
    __syncthreads();
}

DI void gla_scan(const Params& p) {
    const int gt = blockIdx.x * NT + tid_fresh(), nth = gridDim.x * NT;
    for (int e = gt; e < 131072; e += nth) {
        const int h = e >> 15, dk = e & 127;
        bf16_t* kv = (bf16_t*)(p.ws + KVT) + e; const float* dec = (const float*)(p.ws + DEC) + h * 128 + dk;
        float s0 = 0.f;
        for (int n = 0; n < 256; n += 16) {
            bf16_t v[16]; float d[16];
#pragma unroll
            for (int q = 0; q < 16; ++q) { v[q] = kv[(size_t)(n + q) * 131072]; d[q] = dec[(size_t)(n + q) * 512]; }
#pragma unroll
            for (int q = 0; q < 16; ++q) { kv[(size_t)(n + q) * 131072] = f2bf(s0); s0 = d[q] * s0 + bf2f(v[q]); }
        }
    }
}

DI void gla_out_unit(const Params& p, int u, char* smem) {
    float* gl_s = (float*)smem; float* tot_s = gl_s + 1024; float* ss_s = tot_s + 256; bf16_t* qdec_s = (bf16_t*)(ss_s + 256);
    bf16_t* kinv_s = qdec_s + 64 * 136; bf16_t* attn_s = kinv_s + 64 * 136;
    const int tid = tid_fresh() & 255, c = tid & 127, hf = tid >> 7, lane = tid & 63, w = tid >> 6, lr = lane & 15, lq = lane >> 4;
    const int n = u >> 2, h = u & 3;
    float bcum[32], blast; gla_gate(p, n, h, gl_s, tot_s, bcum, blast);
    {
        const bf16_t* qp = (const bf16_t*)(p.ws + QK) + (size_t)(n * 64 + hf * 32) * 1024 + h * 128 + c;
#pragma unroll
        for (int i = 0; i < 32; ++i) {
            const float q = bf2f(qp[(size_t)i * 1024]), k = bf2f(qp[(size_t)i * 1024 + 512]);
            const int row = hf * 32 + i;
            qdec_s[row * 136 + c] = f2bf(q * 0.08838834764831845f * __expf(bcum[i]));
            kinv_s[row * 136 + c] = f2bf(k * __expf(-bcum[i]));
        }
    }
    __syncthreads();
    {
        bf16x8 qf[4];
#pragma unroll
        for (int kk = 0; kk < 4; ++kk) qf[kk] = *(const bf16x8*)(qdec_s + (w * 16 + lr) * 136 + kk * 32 + lq * 8);
#pragma unroll
        for (int jt = 0; jt < 4; ++jt) {
            f32x4 a = (f32x4){0.f, 0.f, 0.f, 0.f};
            if (jt <= w) {
#pragma unroll
                for (int kk = 0; kk < 4; ++kk) { const bf16x8 kf = *(const bf16x8*)(kinv_s + (jt * 16 + lr) * 136 + kk * 32 + lq * 8); a = mfma16(kf, qf[kk], a); }
            }
            const int i = w * 16 + lr, j0 = jt * 16 + lq * 4;
#pragma unroll
            for (int jj = 0; jj < 4; ++jj) if (j0 + jj > i) a[jj] = 0.f;
            u32x2 wv; wv.x = pack2(a[0], a[1]); wv.y = pack2(a[2], a[3]); *(u32x2*)(attn_s + i * 72 + j0) = wv;
        }
    }
    __syncthreads();
    f32x4 acc[4][4];
#pragma unroll
    for (int a = 0; a < 4; ++a)
#pragma unroll
        for (int b = 0; b < 4; ++b) acc[a][b] = (f32x4){0.f, 0.f, 0.f, 0.f};
    const int dv0 = w * 64;
    {
        const bf16_t* vt = (const bf16_t*)(p.ws + VT) + ((size_t)u * 256 + dv0) * 64;
#pragma unroll
        for (int kk = 0; kk < 2; ++kk) {
            bf16x8 af[4];
#pragma unroll
            for (int it = 0; it < 4; ++it) af[it] = *(const bf16x8*)(attn_s + (it * 16 + lr) * 72 + kk * 32 + lq * 8);
#pragma unroll
            for (int dt = 0; dt < 4; ++dt) { const bf16x8 vf = *(const bf16x8*)(vt + (dt * 16 + lr) * 64 + kk * 32 + lq * 8);
#pragma unroll
                for (int it = 0; it < 4; ++it) acc[dt][it] = mfma16(vf, af[it], acc[dt][it]); }
        }
        const bf16_t* sp = (const bf16_t*)(p.ws + KVT) + ((size_t)u * 256 + dv0) * 128;
#pragma unroll
        for (int kk = 0; kk < 4; ++kk) {
            bf16x8 qf[4];
#pragma unroll
            for (int it = 0; it < 4; ++it) qf[it] = *(const bf16x8*)(qdec_s + (it * 16 + lr) * 136 + kk * 32 + lq * 8);
#pragma unroll
            for (int dt = 0; dt < 4; ++dt) { const bf16x8 sf = *(const bf16x8*)(sp + (dt * 16 + lr) * 128 + kk * 32 + lq * 8);
#pragma unroll
                for (int it = 0; it < 4; ++it) acc[dt][it] = mfma16(sf, qf[it], acc[dt][it]); }
        }
    }
#pragma unroll
    for (int it = 0; it < 4; ++it) {
        float ss = 0.f;
#pragma unroll
        for (int dt = 0; dt < 4; ++dt) { const f32x4 a = acc[dt][it]; ss += a[0] * a[0] + a[1] * a[1] + a[2] * a[2] + a[3] * a[3]; }
        ss += __shfl_xor(ss, 16); ss += __shfl_xor(ss, 32);
        if (lq == 0) ss_s[w * 64 + it * 16 + lr] = ss;
    }
    __syncthreads();
    const bf16_t* rb = (const bf16_t*)(p.ws + RB); bf16_t* og = (bf16_t*)(p.ws + XH);
#pragma unroll
    for (int it = 0; it < 4; ++it) {
        const int i = it * 16 + lr; const float tot = ss_s[i] + ss_s[64 + i] + ss_s[128 + i] + ss_s[192 + i];
        const float rstd = rsqrtf(tot * (1.f / 256.f) + EPS);
        const size_t rowoff = (size_t)(n * 64 + i) * 1024 + h * 256;
#pragma unroll
        for (int dt = 0; dt < 4; ++dt) {
            const int dv = dv0 + dt * 16 + lq * 4; const f32x4 gn = *(const f32x4*)(p.a_out_norm + dv); const u32x2 rr = *(const u32x2*)(rb + rowoff + dv); const f32x4 a = acc[dt][it];
            u32x2 wv; wv.x = pack2(nopack(nopack(a[0] * rstd) * nopack(gn[0] * bflo(rr.x))), nopack(nopack(a[1] * rstd) * nopack(gn[1] * bfhi(rr.x)))); wv.y = pack2(nopack(nopack(a[2] * rstd) * nopack(gn[2] * bflo(rr.y))), nopack(nopack(a[3] * rstd) * nopack(gn[3] * bfhi(rr.y))));
            *(u32x2*)(og + rowoff + dv) = wv;
        }
    }
    __syncthreads();
}

DI void latent_norm_phase(const Params& p) {
    const int tidf = tid_fresh(); const int lane = tidf & 63; const int gw = (blockIdx.x * NT + tidf) >> 6, nw = (gridDim.x * NT) >> 6;
    for (int s = gw; s < S; s += nw) {
        const float* d = (const float*)(p.ws + DBUF) + (size_t)s * 768;
        const f32x4 a = *(const f32x4*)(d + lane * 4);
        f32x2 b[3];
#pragma unroll
        for (int i = 0; i < 3; ++i) b[i] = *(const f32x2*)(d + 256 + i * 128 + lane * 2);
        float kr = 0.f; if (lane < 32) kr = d[640 + lane];
        float s1 = a[0] * a[0] + a[1] * a[1] + a[2] * a[2] + a[3] * a[3];
        float s2 = b[0].x * b[0].x + b[0].y * b[0].y + b[1].x * b[1].x + b[1].y * b[1].y + b[2].x * b[2].x + b[2].y * b[2].y;
#pragma unroll
        for (int o = 32; o >= 1; o >>= 1) { s1 += __shfl_xor(s1, o); s2 += __shfl_xor(s2, o); }
        const float r1 = rsqrtf(s1 * (1.f / 256.f) + EPS), r2 = rsqrtf(s2 * (1.f / 384.f) + EPS);
        u32x2 wv; wv.x = pack2(a[0] * r1, a[1] * r1); wv.y = pack2(a[2] * r1, a[3] * r1);
        *(u32x2*)((bf16_t*)(p.ws + CKV) + (size_t)s * 256 + lane * 4) = wv;
#pragma unroll
        for (int i = 0; i < 3; ++i) *(unsigned*)((bf16_t*)(p.ws + CQ) + (size_t)s * 384 + i * 128 + lane * 2) = pack2(b[i].x * r2, b[i].y * r2);
        if (lane < 32) ((float*)(p.ws + KROPE))[(size_t)s * 32 + lane] = kr;
    }
}

DI void qk_post_phase(const Params& p) {
    const int gt = blockIdx.x * NT + tid_fresh(), nth = gridDim.x * NT;
    for (int idx = gt; idx < 2 * S * 16; idx += nth) {
        const int isk = idx >= S * 16; const int id = isk ? idx - S * 16 : idx; const int s = id >> 4;
        bf16_t* vp = (bf16_t*)(p.ws + (isk ? KB : QB)) + (size_t)id * 96;
        const float* gain = isk ? p.k_norm : p.b_q_norm;
        float v[96];
#pragma unroll
        for (int i = 0; i < 8; ++i) { const u32x4 t = *(const u32x4*)(vp + i * 8);
            v[i * 8 + 0] = bflo(t.x); v[i * 8 + 1] = bfhi(t.x); v[i * 8 + 2] = bflo(t.y); v[i * 8 + 3] = bfhi(t.y); v[i * 8 + 4] = bflo(t.z); v[i * 8 + 5] = bfhi(t.z); v[i * 8 + 6] = bflo(t.w); v[i * 8 + 7] = bfhi(t.w); }
        if (isk) {
            const float* kr = (const float*)(p.ws + KROPE) + (size_t)s * 32;
#pragma unroll
            for (int i = 0; i < 8; ++i) { const f32x4 t = *(const f32x4*)(kr + i * 4); v[64 + i * 4] = t[0]; v[65 + i * 4] = t[1]; v[66 + i * 4] = t[2]; v[67 + i * 4] = t[3]; }
        } else {
#pragma unroll
            for (int i = 8; i < 12; ++i) { const u32x4 t = *(const u32x4*)(vp + i * 8);
                v[i * 8 + 0] = bflo(t.x); v[i * 8 + 1] = bfhi(t.x); v[i * 8 + 2] = bflo(t.y); v[i * 8 + 3] = bfhi(t.y); v[i * 8 + 4] = bflo(t.z); v[i * 8 + 5] = bfhi(t.z); v[i * 8 + 6] = bflo(t.w); v[i * 8 + 7] = bfhi(t.w); }
        }
        float ss = 0.f;
#pragma unroll
        for (int i = 0; i < 96; ++i) ss += v[i] * v[i];
        const float r = rsqrtf(ss * (1.f / 96.f) + EPS);
#pragma unroll
        for (int i = 0; i < 96; ++i) v[i] = v[i] * r * gain[i];
        const float* rt = (const float*)(p.ws + ROPET) + (size_t)s * 32;
#pragma unroll
        for (int i4 = 0; i4 < 4; ++i4) {
            const f32x4 cs = *(const f32x4*)(rt + i4 * 4), sn = *(const f32x4*)(rt + 16 + i4 * 4);
#pragma unroll
            for (int e = 0; e < 4; ++e) { const int i = i4 * 4 + e; const float x1 = v[64 + i], x2 = v[80 + i]; v[64 + i] = x1 * cs[e] - x2 * sn[e]; v[80 + i] = x1 * sn[e] + x2 * cs[e]; }
        }
        const float osc = isk ? 1.f : 0.14724444302f;
#pragma unroll
        for (int i = 0; i < 12; ++i) { u32x4 t; t.x = pack2(v[i * 8] * osc, v[i * 8 + 1] * osc); t.y = pack2(v[i * 8 + 2] * osc, v[i * 8 + 3] * osc); t.z = pack2(v[i * 8 + 4] * osc, v[i * 8 + 5] * osc); t.w = pack2(v[i * 8 + 6] * osc, v[i * 8 + 7] * osc);
            *(u32x4*)(vp + i * 8) = t; }
    }
}

DI void attn_phase(const Params& p, char* smem, int ctr_idx, bool qpost) {
    bf16_t* Ks = (bf16_t*)smem;
    bf16_t* Vs = Ks + 2 * 128 * 104;
    int* sh_u = (int*)(Vs + 2 * 64 * 136);
    const int tid = tid_fresh(), lane = tid & 63, w = tid >> 6, l31 = lane & 31, lh = lane >> 5;
    const int pi = (l31 & 0x13) | ((l31 & 4) << 1) | ((l31 & 8) >> 1);
    int koff_g[3], koff_l[3];
#pragma unroll
    for (int i = 0; i < 3; ++i) { const int c = tid + 512 * i; const int row = c / 12, part = c - row * 12; koff_g[i] = row * 16 * 96 + part * 8; koff_l[i] = row * 104 + part * 8; }
    const int voff_g0 = (tid >> 4) * S + (tid & 15) * 8, voff_l0 = (tid >> 4) * 136 + (tid & 15) * 8;
#define voff_g(i) (voff_g0 + (i) * 32 * S)
#define voff_l(i) (voff_l0 + (i) * 32 * 136)
    if (tid == 0) sh_u[1] = 0;
    for (int xi = 0; xi < 8; ++xi) {
    const int xq = ((int)(xb_xcc_id() & 7u) + xi) & 7;
    for (;;) {
        if (tid == 0) *sh_u = (int)atomicAdd((unsigned*)(p.ws + MISC) + ctr_idx * 512 + xq * 64, 1u);
        __syncthreads();
        const int u = *sh_u;
        __syncthreads();
        if (u >= 128) break;
        const int qt = 63 - (u >> 1), h = xq * 2 + (u & 1), q0 = qt * 256;
        const int nst = 2 * qt + 2, my_nkt = 4 * qt + 1 + (w >> 1);
        const bool sticky = __builtin_amdgcn_readfirstlane(sh_u[1]) != 0;
        for (int attempt = 0;; ++attempt) {
        const bool trk = sticky || attempt > 0;
        bf16x8 qf[6];
        {
            const bf16_t* qp = (const bf16_t*)(p.ws + QB) + ((size_t)(q0 + w * 32 + l31) * 16 + h) * 96 + lh * 8;
#pragma unroll
            for (int ks = 0; ks < 6; ++ks) qf[ks] = *(const bf16x8*)(qp + ks * 16);
        }
        if (qpost) {
            const int tok = q0 + w * 32 + l31;
            float v[6][8]; float ss = 0.f;
#pragma unroll
            for (int ks = 0; ks < 6; ++ks)
#pragma unroll
                for (int e = 0; e < 8; ++e) { v[ks][e] = bf2f((bf16_t)qf[ks][e]); ss += v[ks][e] * v[ks][e]; }
            ss += __shfl_xor(ss, 32);
            const float rs = rsqrtf(ss * (1.f / 96.f) + EPS);
#pragma unroll
            for (int ks = 0; ks < 6; ++ks) {
                const int d0 = ks * 16 + lh * 8; const f32x4 ga = *(const f32x4*)(p.b_q_norm + d0), gb = *(const f32x4*)(p.b_q_norm + d0 + 4);
#pragma unroll
                for (int e = 0; e < 4; ++e) { v[ks][e] *= rs * ga[e]; v[ks][e + 4] *= rs * gb[e]; }
                if (ks < 4) { const f32x4 ka = *(const f32x4*)(p.k_norm + d0), kb2 = *(const f32x4*)(p.k_norm + d0 + 4);
#pragma unroll
                    for (int e = 0; e < 4; ++e) { v[ks][e] *= ka[e]; v[ks][e + 4] *= kb2[e]; } }
            }
            {
                const float* rt = (const float*)(p.ws + ROPET) + (size_t)tok * 32 + lh * 8;
                const f32x4 c0 = *(const f32x4*)(rt), c1 = *(const f32x4*)(rt + 4), s0 = *(const f32x4*)(rt + 16), s1 = *(const f32x4*)(rt + 20);
#pragma unroll
                for (int e = 0; e < 4; ++e) {
                    { const float x1 = v[4][e], x2 = v[5][e]; v[4][e] = x1 * c0[e] - x2 * s0[e]; v[5][e] = x1 * s0[e] + x2 * c0[e]; }
                    { const float x1 = v[4][e + 4], x2 = v[5][e + 4]; v[4][e + 4] = x1 * c1[e] - x2 * s1[e]; v[5][e + 4] = x1 * s1[e] + x2 * c1[e]; }
                }
            }
            const float osc = 0.14724444302f;
#pragma unroll
            for (int ks = 0; ks < 6; ++ks) { u32x4 t; t.x = pack2(v[ks][0] * osc, v[ks][1] * osc); t.y = pack2(v[ks][2] * osc, v[ks][3] * osc); t.z = pack2(v[ks][4] * osc, v[ks][5] * osc); t.w = pack2(v[ks][6] * osc, v[ks][7] * osc);
                qf[ks] = __builtin_bit_cast(bf16x8, t); }
        }
        f32x16 O0, O1, negm;
#pragma unroll
        for (int i = 0; i < 16; ++i) { O0[i] = 0.f; O1[i] = 0.f; negm[i] = 0.f; }
        float lsum = 0.f;
        const bf16_t* Kh = (const bf16_t*)(p.ws + KB) + h * 96; const bf16_t* Vh = (const bf16_t*)(p.ws + VTM) + (size_t)h * 64 * S;
        u32x4 rk[3], rv[2];
#pragma unroll
        for (int i = 0; i < 3; ++i) rk[i] = *(const u32x4*)(Kh + koff_g[i]);
#pragma unroll
        for (int i = 0; i < 2; ++i) rv[i] = *(const u32x4*)(Vh + voff_g(i));
#pragma unroll
        for (int i = 0; i < 3; ++i) *(u32x4*)(Ks + koff_l[i]) = rk[i];
#pragma unroll
        for (int i = 0; i < 2; ++i) *(u32x4*)(Vs + voff_l(i)) = rv[i];
        __syncthreads();
        for (int st = 0; st < nst; ++st) {
            const int buf = st & 1; const bool more = st + 1 < nst;
            if (more) {
#pragma unroll
                for (int i = 0; i < 3; ++i) rk[i] = *(const u32x4*)(Kh + (size_t)(st + 1) * 128 * 16 * 96 + koff_g[i]);
#pragma unroll
                for (int i = 0; i < 2; ++i) rv[i] = *(const u32x4*)(Vh + (st + 1) * 128 + voff_g(i));
            }
#pragma unroll
            for (int sub = 0; sub < 2; ++sub) {
                const int tile = st * 2 + sub;
                if (tile < my_nkt) {
                    const bf16_t* kb = Ks + buf * 128 * 104 + (sub * 64 + pi) * 104 + lh * 8; const bf16_t* vb = Vs + buf * 64 * 136 + l31 * 136 + sub * 64 + lh * 8;
                    f32x16 s0, s1;
                    bf16x8 kf[12], vf[8];
#pragma unroll
                    for (int ks = 0; ks < 6; ++ks) { kf[2 * ks] = *(const bf16x8*)(kb + ks * 16); kf[2 * ks + 1] = *(const bf16x8*)(kb + 32 * 104 + ks * 16); }
                    __builtin_amdgcn_sched_barrier(0);
#pragma unroll
                    for (int ks = 0; ks < 4; ++ks) { vf[2 * ks] = *(const bf16x8*)(vb + ks * 16); vf[2 * ks + 1] = *(const bf16x8*)(vb + 32 * 136 + ks * 16); }
                    s0 = mfma32(kf[0], qf[0], negm); s1 = mfma32(kf[1], qf[0], negm);
#pragma unroll
                    for (int ks = 1; ks < 6; ++ks) { s0 = mfma32(kf[2 * ks], qf[ks], s0); s1 = mfma32(kf[2 * ks + 1], qf[ks], s1); }
                    __builtin_amdgcn_sched_barrier(0);
                    if (tile == 0 || trk) {
                    float mx = fmaxf(s0[0], s0[1]), mx1 = fmaxf(s1[0], s1[1]);
#pragma unroll
                    for (int i = 2; i < 16; i += 2) { mx = fmaxf(fmaxf(mx, s0[i]), s0[i + 1]); mx1 = fmaxf(fmaxf(mx1, s1[i]), s1[i + 1]); }
                    mx = fmaxf(mx, mx1);
                    { const auto sw = __builtin_amdgcn_permlane32_swap(__float_as_uint(mx), __float_as_uint(mx), false, false);
                      mx = fmaxf(__uint_as_float(sw[0]), __uint_as_float(sw[1])); }
                    if (tile == 0 || __any(mx > 8.f)) {
                        const float d = (tile == 0 || mx > 8.f) ? mx : 0.f;
                        const float alpha = __builtin_amdgcn_exp2f(-d);
                        lsum *= alpha;
#pragma unroll
                        for (int i = 0; i < 16; ++i) { O0[i] *= alpha; O1[i] *= alpha; s0[i] -= d; s1[i] -= d; negm[i] -= d; }
                    }
                    }
                    float r0 = 0.f, r1 = 0.f, r2 = 0.f, r3 = 0.f;
#pragma unroll
                    for (int i = 0; i < 16; i += 2) {
                        s0[i] = __builtin_amdgcn_exp2f(s0[i]); s0[i + 1] = __builtin_amdgcn_exp2f(s0[i + 1]); s1[i] = __builtin_amdgcn_exp2f(s1[i]); s1[i + 1] = __builtin_amdgcn_exp2f(s1[i + 1]);
                        r0 += s0[i]; asm("" : "+v"(r0)); r1 += s0[i + 1]; asm("" : "+v"(r1)); r2 += s1[i]; asm("" : "+v"(r2)); r3 += s1[i + 1]; asm("" : "+v"(r3));
                    }
                    lsum += (r0 + r1) + (r2 + r3);
                    bf16x8 pf[4];
                    {
                        u32x4 t;
                        t.x = pack2(s0[0], s0[1]); t.y = pack2(s0[2], s0[3]); t.z = pack2(s0[4], s0[5]); t.w = pack2(s0[6], s0[7]); pf[0] = __builtin_bit_cast(bf16x8, t);
                        t.x = pack2(s0[8], s0[9]); t.y = pack2(s0[10], s0[11]); t.z = pack2(s0[12], s0[13]); t.w = pack2(s0[14], s0[15]); pf[1] = __builtin_bit_cast(bf16x8, t);
                        t.x = pack2(s1[0], s1[1]); t.y = pack2(s1[2], s1[3]); t.z = pack2(s1[4], s1[5]); t.w = pack2(s1[6], s1[7]); pf[2] = __builtin_bit_cast(bf16x8, t);
                        t.x = pack2(s1[8], s1[9]); t.y = pack2(s1[10], s1[11]); t.z = pack2(s1[12], s1[13]); t.w = pack2(s1[14], s1[15]); pf[3] = __builtin_bit_cast(bf16x8, t);
                    }
#pragma unroll
                    for (int ks = 0; ks < 4; ++ks) { O0 = mfma32(vf[2 * ks], pf[ks], O0); O1 = mfma32(vf[2 * ks + 1], pf[ks], O1); }
                }
            }
            if (more) {
                bf16_t* kw = Ks + (buf ^ 1) * 128 * 104; bf16_t* vw = Vs + (buf ^ 1) * 64 * 136;
#pragma unroll
                for (int i = 0; i < 3; ++i) *(u32x4*)(kw + koff_l[i]) = rk[i];
#pragma unroll
                for (int i = 0; i < 2; ++i) *(u32x4*)(vw + voff_l(i)) = rv[i];
            }
            __syncthreads();
        }
        const float lt = lsum + __shfl_xor(lsum, 32);
        if (!trk) { const int bad = !(lt > 0.f && lt < 1e37f); if (__syncthreads_or(bad)) { if (tid == 0) sh_u[1] = 1; continue; } }
        const float inv = 1.f / lt;
        bf16_t* op = (bf16_t*)(p.ws + XH) + (size_t)(q0 + w * 32 + l31) * 1024 + h * 64 + lh * 4;
#pragma unroll
        for (int gq = 0; gq < 4; ++gq) {
            u32x2 a; a.x = pack2(O0[gq * 4] * inv, O0[gq * 4 + 1] * inv); a.y = pack2(O0[gq * 4 + 2] * inv, O0[gq * 4 + 3] * inv); *(u32x2*)(op + gq * 8) = a;
            u32x2 b; b.x = pack2(O1[gq * 4] * inv, O1[gq * 4 + 1] * inv); b.y = pack2(O1[gq * 4 + 2] * inv, O1[gq * 4 + 3] * inv); *(u32x2*)(op + 32 + gq * 8) = b;
        }
        break;
        }
    }
    }
}

DI void gl_phase(const Params& p, char* smem) {
    const int tid = tid_fresh(), lane = tid & 63, w = tid >> 6, mt = w & 3, kh = w >> 2, lr = lane & 15, lq = lane >> 4;
    float* part = (float*)smem;
    for (int ch = blockIdx.x; ch < 256; ch += gridDim.x) {
        const bf16_t* xa = (const bf16_t*)(p.ws + XH) + (size_t)(ch * 64 + mt * 16 + lr) * 1024 + kh * 512 + lq * 8;
        const bf16_t* wb = (const bf16_t*)(p.ws + W_GL) + (size_t)lr * 1024 + kh * 512 + lq * 8;
        bf16x8 xf[16], wf[16];
#pragma unroll
        for (int ks = 0; ks < 16; ++ks) { xf[ks] = *(const bf16x8*)(xa + ks * 32); wf[ks] = *(const bf16x8*)(wb + ks * 32); }
        f32x4 acc = (f32x4){0.f, 0.f, 0.f, 0.f};
#pragma unroll
        for (int ks = 0; ks < 16; ++ks) acc = mfma16(wf[ks], xf[ks], acc);
        if (kh == 1) *(f32x4*)(part + (mt * 64 + lane) * 4) = acc;
        __syncthreads();
        if (kh == 0) { const f32x4 o = acc + *(const f32x4*)(part + (mt * 64 + lane) * 4); *(f32x4*)((float*)(p.ws + GL) + ((size_t)ch * 64 + mt * 16 + lr) * 16 + lq * 4) = o; }
        __syncthreads();
    }
}

constexpr int NPH = 19;
DI void run_phase(const Params& p, int ph, char* smem) {
    const int dup = ph >= 100; if (dup) ph -= 100;
    const int G = gridDim.x, b = blockIdx.x;
    bf16_t* xh = (bf16_t*)(p.ws + XH);
    switch (ph) {
    case 0: {
        const int total = p.jstart[NJOBS]; const int tidp = tid_fresh();
        for (int t0 = b * 4; t0 < total; t0 += G * 4) {
#pragma unroll
            for (int q = 0; q < 4; ++q) { const int t = t0 + q; if (t < total) { int j = 0; while (t >= p.jstart[j + 1]) ++j; tr_load(p.jobs[j], t - p.jstart[j], (float*)smem + q * 64 * 65, tidp); } }
            __syncthreads();
#pragma unroll
            for (int q = 0; q < 4; ++q) { const int t = t0 + q; if (t < total) { int j = 0; while (t >= p.jstart[j + 1]) ++j; tr_store(p.jobs[j], t - p.jstart[j], (const float*)smem + q * 64 * 65, tidp); } }
            __syncthreads();
        }
        norm_phase(p.x, xh);
        { float* rt = (float*)(p.ws + ROPET);
          for (int idx = b * NT + tid_fresh(); idx < S * 16; idx += G * NT) { const int s = idx >> 4, i = idx & 15; const float ang = (float)p.pos[s] * p.inv_freq[i]; rt[s * 32 + i] = cosf(ang); rt[s * 32 + 16 + i] = sinf(ang); } }
    } break;
    case 1: { Epi<EPI_INPROJ> E{}; E.o0 = (bf16_t*)(p.ws + QK); E.o1 = (bf16_t*)(p.ws + VT); E.o2 = (bf16_t*)(p.ws + RB); E.outf = (float*)(p.ws + GL);
        gemm_phase<EPI_INPROJ>(xh, (const bf16_t*)(p.ws + W_IN), 3072, 1024, E, smem); gl_phase(p, smem); } break;
    case 2: { const int hf2 = tid_fresh() >> 8; for (int u0 = b * 2; u0 < 1024; u0 += 2 * G) gla_kv_unit(p, u0 + hf2, smem + hf2 * 53248); } break;
    case 3: gla_scan(p); break;
    case 4: { const int hf2 = tid_fresh() >> 8; for (int u0 = b * 2; u0 < 1024; u0 += 2 * G) gla_out_unit(p, u0 + hf2, smem + hf2 * 53248); } break;
    case 5: case 15: if (G == 256) { EpiResNorm E{}; E.res = ph == 5 ? p.x : p.out; E.outf = p.out; E.xh = xh; E.xbuf = (float*)(p.ws + XSLOT) + (ph == 5 ? 0 : 2 * 4 * S); E.cnt = (unsigned*)(p.ws + PCNT) + (ph == 5 ? 0 : 2 * 4096);
            gemm_phase_resnorm(xh, (const bf16_t*)(p.ws + (ph == 5 ? W_AOUT : W_BOUT)), 1024, E, smem); }
        else { Epi<EPI_RES> E{}; E.res = ph == 5 ? p.x : p.out; E.outf = p.out;
            gemm_phase<EPI_RES>(xh, (const bf16_t*)(p.ws + (ph == 5 ? W_AOUT : W_BOUT)), 1024, 1024, E, smem); } break;
    case 6: case 9: case 16: norm_phase(p.out, xh); break;
    case 7: case 17: { const int l = ph == 17; Epi<EPI_SWIGLU> E{}; E.o0 = (bf16_t*)(p.ws + HB);
        gemm_phase<EPI_SWIGLU>(xh, (const bf16_t*)(p.ws + W_FIN) + (size_t)l * 5632 * 1024, 5632, 1024, E, smem); } break;
    case 8: if (G == 256) { EpiResNorm E{}; E.res = p.out; E.outf = p.out; E.xh = xh; E.xbuf = (float*)(p.ws + XSLOT) + 4 * S; E.cnt = (unsigned*)(p.ws + PCNT) + 4096;
            gemm_phase_resnorm((const bf16_t*)(p.ws + HB), (const bf16_t*)(p.ws + W_FOUT), 2816, E, smem); break; }
    case 18: { const int l = ph == 18; Epi<EPI_RES> E{}; E.res = p.out; E.outf = p.out;
        gemm_phase<EPI_RES>((const bf16_t*)(p.ws + HB), (const bf16_t*)(p.ws + W_FOUT) + (size_t)l * 1024 * 2816, 1024, 2816, E, smem); } break;
    case 10: if (G == 256) { EpiLatent E{}; E.ckv = (bf16_t*)(p.ws + CKV); E.cq = (bf16_t*)(p.ws + CQ); E.krope = (float*)(p.ws + KROPE); E.xbuf = (float*)(p.ws + XSLOT) + 3 * 4 * S; E.cnt = (unsigned*)(p.ws + PCNT) + 3 * 4096; E.ropet = (const float*)(p.ws + ROPET); E.kgain = p.k_norm; E.krss = (float*)(p.ws + KRSS);
            gemm_phase_latent(xh, (const bf16_t*)(p.ws + W_DD), E, smem); }
        else { Epi<EPI_F32> E{}; E.outf = (float*)(p.ws + DBUF); E.ldo = 768;
            gemm_phase<EPI_F32>(xh, (const bf16_t*)(p.ws + W_DD), 768, 1024, E, smem); } break;
    case 11: latent_norm_phase(p); break;
    case 12: {
        if (G == 256) { EpiKV2 E{}; E.kb = (bf16_t*)(p.ws + KB); E.vt = (bf16_t*)(p.ws + VTM); E.krss = (const float*)(p.ws + KRSS); E.krope = (const float*)(p.ws + KROPE);
          gemm_phase_kv2((const bf16_t*)(p.ws + CKV), (const bf16_t*)(p.ws + W_UP), E, smem); }
        else { Epi<EPI_KV> E{}; E.o0 = (bf16_t*)(p.ws + KB); E.o1 = (bf16_t*)(p.ws + VTM);
          gemm_phase<EPI_KV>((const bf16_t*)(p.ws + CKV), (const bf16_t*)(p.ws + W_UP), 2048, 256, E, smem); }
        { Epi<EPI_BF16> E{}; E.o0 = (bf16_t*)(p.ws + QB); E.ldo = 1536;
          gemm_phase<EPI_BF16>((const bf16_t*)(p.ws + CQ), (const bf16_t*)(p.ws + W_UQ), 1536, 384, E, smem); }
    } break;
    case 13: qk_post_phase(p); break;
    case 14: attn_phase(p, smem, dup, G == 256); break;
    default: break;
    }
}

__global__ void __launch_bounds__(NT, 2) yoco_mega(const Params p) {
    extern __shared__ __attribute__((aligned(16))) char smem[];
#if MULTI_LAUNCH
    run_phase(p, p.ph_lo, smem);
#else
    cg::grid_group grid = cg::this_grid();
    __shared__ uint4 xb_words;
    if (threadIdx.x == 0) xb_words = make_uint4(0u, 0u, 0u, 0u);
    __syncthreads();
    XcdBarrier xb = xcd_barrier_post((unsigned*)(p.ws + MISC_BAR), (volatile LAS unsigned*)&xb_words);
    if (p.ph_hi == 0x7fffffff) grid.sync();
    run_phase(p, 0, smem); xcd_barrier(xb);
#ifdef DUP0
    run_phase(p, 0, smem); xcd_barrier(xb);
#endif
#ifndef DUP
#define DUP 0
#endif
#define PHASE(n) run_phase(p, n, smem); xcd_barrier(xb); if ((DUP >> n) & 1) { run_phase(p, n + 100, smem); xcd_barrier(xb); }
    PHASE(1) PHASE(2) PHASE(3) PHASE(4)
#ifdef DUPGLA
    PHASE(2) PHASE(3) PHASE(4)
#endif
    const bool fuse = gridDim.x == 256;
    PHASE(5) if (!fuse) { PHASE(6) } PHASE(7) PHASE(8) if (!fuse) { PHASE(9) }
    PHASE(10) if (!fuse) { PHASE(11) } PHASE(12) if (!fuse) { PHASE(13) } PHASE(14) PHASE(15) if (!fuse) { PHASE(16) } PHASE(17)
    run_phase(p, 18, smem);
#undef PHASE
#endif
}

extern "C" void kernel_launch(void* const* d_in, const int* in_sizes, int n_in, void* d_out, int out_size, void* d_ws, size_t ws_size, hipStream_t stream) {
    static int grid_blocks = 0;
    if (grid_blocks == 0) {
        if (n_in != 22 || ws_size < WS_NEED) { fprintf(stderr, "kernel_launch: unexpected n_in %d / ws %zu (need %zu)\n", n_in, ws_size, (size_t)WS_NEED); grid_blocks = -1; return; }
        int dev = 0, cus = 0, per_cu = 0;
        hipGetDevice(&dev); hipDeviceGetAttribute(&cus, hipDeviceAttributeMultiprocessorCount, dev);
        if (hipFuncSetAttribute((const void*)yoco_mega, hipFuncAttributeMaxDynamicSharedMemorySize, LDS_BYTES) != hipSuccess) { fprintf(stderr, "kernel_launch: hipFuncSetAttribute failed\n"); grid_blocks = -1; return; }
        if (hipOccupancyMaxActiveBlocksPerMultiprocessor(&per_cu, (const void*)yoco_mega, NT, LDS_BYTES) != hipSuccess || per_cu < 1) { fprintf(stderr, "kernel_launch: occupancy query failed (%d)\n", per_cu); grid_blocks = -1; return; }
        if (per_cu > 1) per_cu = 1;
        grid_blocks = cus * per_cu;
        fprintf(stderr, "kernel_launch: cus %d per_cu %d grid %d\n", cus, per_cu, grid_blocks);
    }
    if (grid_blocks < 0) return;
    Params p; memset(&p, 0, sizeof(p));
    p.x = (const float*)d_in[0]; p.pos = (const int*)d_in[1];
    p.a_norm = (const float*)d_in[2]; p.a_w_in = (const float*)d_in[3]; p.a_w_gate_up = (const float*)d_in[4]; p.a_b_gate = (const float*)d_in[5]; p.a_out_norm = (const float*)d_in[6]; p.a_w_out = (const float*)d_in[7];
    p.b_norm = (const float*)d_in[8]; p.b_w_dq = (const float*)d_in[9]; p.b_q_latent_norm = (const float*)d_in[10]; p.b_w_uq = (const float*)d_in[11]; p.b_q_norm = (const float*)d_in[12]; p.b_w_out = (const float*)d_in[13];
    p.kv_norm = (const float*)d_in[14]; p.kv_w_down = (const float*)d_in[15]; p.kv_latent_norm = (const float*)d_in[16]; p.kv_w_up = (const float*)d_in[17]; p.k_norm = (const float*)d_in[18];
    p.f_norm = (const float*)d_in[19]; p.f_w_in = (const float*)d_in[20]; p.f_w_out = (const float*)d_in[21];
    p.out = (float*)d_out; p.ws = (char*)d_ws;
    char* ws = (char*)d_ws;
    auto job = [&](int i, const float* src, const float* gain, size_t dst, int ldn, int col0, int nvalid, int nrows, int K, int mode) {
        p.jobs[i].src = src; p.jobs[i].gain = gain; p.jobs[i].dst = (bf16_t*)(ws + dst); p.jobs[i].ldn = ldn; p.jobs[i].col0 = col0; p.jobs[i].nvalid = nvalid; p.jobs[i].nrows = nrows; p.jobs[i].K = K; p.jobs[i].mode = mode; };
    job(0, p.a_w_in, p.a_norm, W_IN, 3088, 0, 3072, 3072, 1024, 0);
    job(12, p.a_w_in, p.a_norm, W_GL, 3088, 3072, 16, 64, 1024, 0);
    job(1, p.a_w_out, nullptr, W_AOUT, 1024, 0, 1024, 1024, 1024, 0);
    job(2, p.f_w_in, p.f_norm, W_FIN, 5632, 0, 5632, 5632, 1024, 1);
    job(3, p.f_w_in + (size_t)1024 * 5632, p.f_norm + 1024, W_FIN + (size_t)5632 * 1024 * 2, 5632, 0, 5632, 5632, 1024, 1);
    job(4, p.f_w_out, nullptr, W_FOUT, 1024, 0, 1024, 1024, 2816, 0);
    job(5, p.f_w_out + (size_t)2816 * 1024, nullptr, W_FOUT + (size_t)1024 * 2816 * 2, 1024, 0, 1024, 1024, 2816, 0);
    job(6, p.kv_w_down, p.kv_norm, W_DD, 288, 0, 256, 256, 1024, 0);
    job(7, p.b_w_dq, p.b_norm, W_DD + (size_t)256 * 1024 * 2, 384, 0, 384, 384, 1024, 0);
    job(8, p.kv_w_down, p.kv_norm, W_DD + (size_t)640 * 1024 * 2, 288, 256, 32, 128, 1024, 0);
    job(9, p.kv_w_up, p.kv_latent_norm, W_UP, 2048, 0, 2048, 2048, 256, grid_blocks == 256 ? 2 : 0);
    job(10, p.b_w_uq, p.b_q_latent_norm, W_UQ, 1536, 0, 1536, 1536, 384, 0);
    job(11, p.b_w_out, nullptr, W_BOUT, 1024, 0, 1024, 1024, 1024, 0);
    p.jstart[0] = 0;
    for (int i = 0; i < NJOBS; ++i) p.jstart[i + 1] = p.jstart[i] + (p.jobs[i].nrows / 64) * (p.jobs[i].K / 64);
    for (int i = 0; i < 16; ++i) p.inv_freq[i] = (float)pow(10000.0, -(double)i / 16.0);
    if (hipMemsetAsync(ws + MISC, 0, MISC_ZERO_BYTES, stream) != hipSuccess) fprintf(stderr, "kernel_launch: memset failed\n");
#if MULTI_LAUNCH
    for (int ph = 0; ph < NPH; ++ph) { p.ph_lo = ph; p.ph_hi = ph + 1; hipLaunchKernelGGL(yoco_mega, dim3(grid_blocks), dim3(NT), LDS_BYTES, stream, p); }
#else
    void* args[] = {(void*)&p};
    hipError_t e = hipLaunchCooperativeKernel((const void*)yoco_mega, dim3(grid_blocks), dim3(NT), args, LDS_BYTES, stream);
    if (e != hipSuccess) fprintf(stderr, "kernel_launch: cooperative launch failed: %s (grid %d)\n", hipGetErrorString(e), grid_blocks);
#endif
}
```

```cpp
#include <hip/hip_runtime.h>
#include <hip/hip_cooperative_groups.h>
#include <stdint.h>
#include <stdio.h>
#include <string.h>
#include <math.h>
namespace cg = cooperative_groups;

#ifndef MULTI_LAUNCH
#define MULTI_LAUNCH 0
#endif

typedef unsigned short bf16_t;
typedef short bf16x8 __attribute__((ext_vector_type(8)));
typedef float f32x2 __attribute__((ext_vector_type(2)));
typedef float f32x4 __attribute__((ext_vector_type(4)));
typedef float f32x16 __attribute__((ext_vector_type(16)));
typedef unsigned u32x2 __attribute__((ext_vector_type(2)));
typedef unsigned u32x4 __attribute__((ext_vector_type(4)));
typedef __bf16 bf16v2 __attribute__((ext_vector_type(2)));

#define DI __device__ __forceinline__
DI unsigned pack2(float a, float b) { f32x2 v = {a, b}; return __builtin_bit_cast(unsigned, __builtin_convertvector(v, bf16v2)); }
DI bf16_t f2bf(float a) { return (bf16_t)(pack2(a, 0.f) & 0xffffu); }
DI float bf2f(bf16_t v) { return __uint_as_float(((unsigned)v) << 16); }
DI float bflo(unsigned u) { return __uint_as_float(u << 16); }
DI float bfhi(unsigned u) { return __uint_as_float(u & 0xffff0000u); }
DI f32x4 mfma16(bf16x8 a, bf16x8 b, f32x4 c) { return __builtin_amdgcn_mfma_f32_16x16x32_bf16(a, b, c, 0, 0, 0); }
DI f32x16 mfma32(bf16x8 a, bf16x8 b, f32x16 c) { return __builtin_amdgcn_mfma_f32_32x32x16_bf16(a, b, c, 0, 0, 0); }
DI float nopack(float x) { asm("" : "+v"(x)); return x; }
DI float siluf(float x) { return x * __builtin_amdgcn_rcpf(1.f + __expf(-x)); }
DI int tid_fresh() { int t = threadIdx.x; asm volatile("" : "+v"(t)); return t; }


#define XB_TMO      128
#define XB_XCNT(j)  (256  + 64 * (j))
#define XB_XSUB(j)  (1280 + 64 * (j))
#define XB_XGEN(j)  (2304 + 64 * (j))
#define XB_TOP      3328
#define XB_TOPGEN   3392
#define XCD_BAR_WORDS 3456
#define XB_SPIN_CAP (1u << 22)
#define LAS __attribute__((address_space(3)))
DI unsigned xb_ld(unsigned* p)              { return __hip_atomic_load(p, __ATOMIC_RELAXED, __HIP_MEMORY_SCOPE_AGENT); }
DI unsigned xb_add(unsigned* p, unsigned v) { return __hip_atomic_fetch_add(p, v, __ATOMIC_RELAXED, __HIP_MEMORY_SCOPE_AGENT); }
DI unsigned xb_xcc_id() { return (unsigned)__builtin_amdgcn_s_getreg((3 << 11) | 20) & 0xFu; }
#define XB_SPIN(cond, bar) do { unsigned _sp = 0; while (cond) { __builtin_amdgcn_s_sleep(1); \
    if ((++_sp & 255u) == 0u) { if (xb_ld(&(bar)[XB_TMO])) break; if (_sp > XB_SPIN_CAP) { atomicAdd(&(bar)[XB_TMO], 1u); break; } } } } while (0)
struct XcdBarrier { unsigned* bar; unsigned x; volatile LAS unsigned* st; };
DI XcdBarrier xcd_barrier_post(unsigned* bar, volatile LAS unsigned* st) {
    XcdBarrier b; b.bar = bar; b.x = xb_xcc_id(); b.st = st;
    if (threadIdx.x == 0) (void)xb_add(&bar[XB_XCNT(b.x)], 1u);
    return b;
}
DI void xcd_barrier_complete(unsigned* bar, unsigned x, unsigned& nloc, unsigned& nx) {
    const unsigned G = gridDim.x * gridDim.y * gridDim.z;
    unsigned sum, cnt, mine, sp = 0u;
    for (;;) {
        sum = 0u; cnt = 0u; mine = 0u;
#pragma unroll
        for (unsigned j = 0; j < 16; ++j) { const unsigned c = xb_ld(&bar[XB_XCNT(j)]); sum += c; cnt += (c > 0u) ? 1u : 0u; mine = (j == x) ? c : mine; }
        if (sum == G) break;
        __builtin_amdgcn_s_sleep(1);
        if ((++sp & 255u) == 0u) { if (xb_ld(&bar[XB_TMO])) break; if (sp > XB_SPIN_CAP) { atomicAdd(&bar[XB_TMO], 1u); break; } }
    }
    nloc = mine > 0u ? mine : 1u; nx = cnt > 0u ? cnt : 1u;
}
DI void xcd_barrier(const XcdBarrier& b) {
    asm volatile("s_waitcnt vmcnt(0)" ::: "memory");
    __syncthreads();
    if (threadIdx.x == 0) {
        unsigned* bar = b.bar;
        __builtin_amdgcn_s_waitcnt(0);
        unsigned nloc = b.st[0], nx = b.st[1];
        if (nloc == 0u) { xcd_barrier_complete(bar, b.x, nloc, nx); b.st[0] = nloc; b.st[1] = nx; }
        const unsigned old = xb_add(&bar[XB_XSUB(b.x)], 1u);
        const unsigned gen = old / nloc;
        if (old + 1u == (gen + 1u) * nloc) {
            __builtin_amdgcn_fence(__ATOMIC_RELEASE, "agent");
            asm volatile("s_waitcnt vmcnt(0)" ::: "memory");
            const unsigned og = xb_add(&bar[XB_TOP], 1u);
            const unsigned tg = og / nx;
            if (og + 1u == (tg + 1u) * nx) xb_add(&bar[XB_TOPGEN], 1u);
            else XB_SPIN(xb_ld(&bar[XB_TOPGEN]) == tg, bar);
            __builtin_amdgcn_fence(__ATOMIC_ACQUIRE, "agent");
            xb_add(&bar[XB_XGEN(b.x)], 1u);
            asm volatile("s_waitcnt vmcnt(0)" ::: "memory");
        } else {
            XB_SPIN(xb_ld(&bar[XB_XGEN(b.x)]) == gen, bar);
            __builtin_amdgcn_fence(__ATOMIC_ACQUIRE, "agent");
            asm volatile("s_waitcnt vmcnt(0)" ::: "memory");
        }
    }
    __syncthreads();
}

constexpr int S = 16384;
constexpr int NT = 512;
constexpr float EPS = 1e-6f;
constexpr size_t MiB = 1u << 20;
constexpr size_t W_IN = 0;
constexpr size_t W_GL = W_IN + (size_t)3072 * 1024 * 2;
constexpr size_t W_AOUT = W_IN + (size_t)3328 * 1024 * 2;
constexpr size_t W_FIN = W_AOUT + (size_t)1024 * 1024 * 2;
constexpr size_t W_FOUT = W_FIN + (size_t)2 * 5632 * 1024 * 2;
constexpr size_t W_DD = W_FOUT + (size_t)2 * 1024 * 2816 * 2;
constexpr size_t W_UP = W_DD + (size_t)768 * 1024 * 2;
constexpr size_t W_UQ = W_UP + (size_t)2048 * 256 * 2;
constexpr size_t W_BOUT = W_UQ + (size_t)1536 * 384 * 2;
constexpr size_t W_END = W_BOUT + (size_t)1024 * 1024 * 2;
static_assert(W_END <= 47 * MiB + 512 * 1024, "weights");
constexpr size_t MISC = 47 * MiB + 512 * 1024;
constexpr size_t MISC_BAR = MISC + 4096;
constexpr size_t PCNT = MISC + 32768;
constexpr size_t MISC_ZERO_BYTES = 32768 + 4 * 16384;
constexpr size_t XH = 48 * MiB;
constexpr size_t R = 80 * MiB;
constexpr size_t QK = R;
constexpr size_t VT = R + 32 * MiB;
constexpr size_t RB = R + 64 * MiB;
constexpr size_t GL = R + 96 * MiB;
constexpr size_t DEC = R + 97 * MiB;
constexpr size_t KVT = R + 98 * MiB;
constexpr size_t HB = R;
constexpr size_t CKV = R;
constexpr size_t CQ = R + 8 * MiB;
constexpr size_t KROPE = R + 20 * MiB;
constexpr size_t DBUF = R + 22 * MiB;
constexpr size_t QB = R + 22 * MiB;
constexpr size_t KB = R + 70 * MiB;
constexpr size_t VTM = R + 118 * MiB;
constexpr size_t ROPET = R + 162 * MiB;
constexpr size_t XSLOT = R + 164 * MiB;
constexpr size_t KRSS = XSLOT + 917504;
constexpr size_t WS_NEED = R + 165 * MiB;
static_assert(WS_NEED <= 256 * MiB, "ws");

constexpr int LDS_BYTES = 131072;

struct TJob { const float* src; const float* gain; bf16_t* dst; int ldn, col0, nvalid, nrows, K, mode; };
constexpr int NJOBS = 13;

struct Params {
    const float* x; const int* pos;
    const float *a_norm, *a_w_in, *a_w_gate_up, *a_b_gate, *a_out_norm, *a_w_out;
    const float *b_norm, *b_w_dq, *b_q_latent_norm, *b_w_uq, *b_q_norm, *b_w_out;
    const float *kv_norm, *kv_w_down, *kv_latent_norm, *kv_w_up, *k_norm;
    const float *f_norm, *f_w_in, *f_w_out;
    float* out; char* ws;
    TJob jobs[NJOBS];
    int jstart[NJOBS + 1];
    int ph_lo, ph_hi, pad0;
    float inv_freq[16];
};

DI void tr_load(const TJob& j, int t, float* tile, int tid) {
    const int ktn = j.K >> 6; const int rt = t / ktn, kt = t - rt * ktn; const int r0 = rt * 64, k0 = kt * 64;
    const int rl = tid & 63, kq = tid >> 6; const int r = r0 + rl; int sc; bool valid;
    if (j.mode == 0) { valid = r < j.nvalid; sc = j.col0 + r; }
    else if (j.mode == 2) { const int cl = r & 255, wcc = (cl >> 5) & 3; sc = ((r >> 8) * 2 + (wcc >> 1)) * 128 + (wcc & 1) * 64 + (cl >> 7) * 32 + (cl & 31); valid = true; }
    else { sc = ((r >> 7) & 1) * 2816 + (r >> 8) * 128 + (r & 127); valid = true; }
    float v[8];
#pragma unroll
    for (int kk = 0; kk < 8; ++kk) { const int k = k0 + kq * 8 + kk; v[kk] = 0.f; if (valid) { v[kk] = __builtin_nontemporal_load(j.src + (size_t)k * j.ldn + sc); if (j.gain) v[kk] *= j.gain[k];     } }
#pragma unroll
    for (int kk = 0; kk < 8; ++kk) tile[(kq * 8 + kk) * 65 + rl] = v[kk];
}
DI void tr_store(const TJob& j, int t, const float* tile, int tid) {
    const int ktn = j.K >> 6; const int rt = t / ktn, kt = t - rt * ktn; const int r0 = rt * 64, k0 = kt * 64;
    const int kl2 = tid & 31, rq = tid >> 5;
#pragma unroll
    for (int rr = 0; rr < 4; ++rr) { const int r = rq * 4 + rr; *(unsigned*)(j.dst + (size_t)(r0 + r) * j.K + k0 + 2 * kl2) = pack2(tile[(2 * kl2) * 65 + r], tile[(2 * kl2 + 1) * 65 + r]); }
}

DI void norm_phase(const float* x, bf16_t* out) {
    const int tidf = tid_fresh(); const int lane = tidf & 63; const int gw = (blockIdx.x * NT + tidf) >> 6, nw = (gridDim.x * NT) >> 6;
    for (int row = gw; row < S; row += nw) {
        const float* xp = x + (size_t)row * 1024 + lane * 4;
        f32x4 v[4]; float ss = 0.f;
#pragma unroll
        for (int i = 0; i < 4; ++i) { v[i] = *(const f32x4*)(xp + i * 256); ss += v[i][0] * v[i][0] + v[i][1] * v[i][1] + v[i][2] * v[i][2] + v[i][3] * v[i][3]; }
#pragma unroll
        for (int o = 32; o >= 1; o >>= 1) ss += __shfl_xor(ss, o);
        const float r = rsqrtf(ss * (1.f / 1024.f) + EPS);
        bf16_t* op = out + (size_t)row * 1024 + lane * 4;
#pragma unroll
        for (int i = 0; i < 4; ++i) { u32x2 w; w.x = pack2(v[i][0] * r, v[i][1] * r); w.y = pack2(v[i][2] * r, v[i][3] * r); *(u32x2*)(op + i * 256) = w; }
    }
}

namespace pg8 {
#define PG8_LAS __attribute__((address_space(3)))
constexpr int BM = 256, BK = 64, HALF = 128, HTB = HALF * BK * 2  , STAGE_BYTES = 8 * HTB, NXCD = 8, WGM = 8;

__host__ __device__ __forceinline__ int lds_byte(int r, int c) { const int st = (r >> 4) * 2 + (c >> 5), rr = r & 15, cc = c & 31, ob = rr * 64 + cc * 2; return st * 1024 + (ob ^ (((ob >> 9) & 1) << 5)); }
__host__ __device__ __forceinline__ void stage_rc(int b, int& R, int& C) { const int st = b / 1024, sb = b % 1024, swz = sb ^ (((sb >> 9) & 1) << 5); R = (st >> 1) * 16 + swz / 64; C = (st & 1) * 32 + (swz % 64) / 2; }
__host__ __device__ __forceinline__ int perm32(int rho) { const int n = rho >> 4, i = rho & 15; return 8 * (i >> 2) + 4 * n + (i & 3); }

struct Unit { int pm, pn; };
struct Gemm { const bf16_t* A; const bf16_t* Bt; int M, N, K; };

struct StaticOrder {
    int nM, nN, nwg, G, c;
    __host__ __device__ void init(int M, int N, int G_, int c_) { nM = M / BM; nN = N / BM; nwg = nM * nN; G = G_; c = c_; }
    __host__ __device__ bool next(int i, Unit& u) const {
        const long L = (long)i * G + c; if (L >= nwg) return false;
        int wgid = (int)L; { const int q = nwg / NXCD, r = nwg % NXCD, xcd = wgid % NXCD, off = wgid / NXCD; wgid = (xcd < r ? xcd * (q + 1) : r * (q + 1) + (xcd - r) * q) + off; }
        const int nig = WGM * nN, gid = wgid / nig, fm = gid * WGM, gsz = (nM - fm) < WGM ? (nM - fm) : WGM;
        u.pm = fm + ((wgid % nig) % gsz); u.pn = (wgid % nig) / gsz; return true;
    }
    __device__ __forceinline__ void a_ready(const Unit&) const {}
    __device__ __forceinline__ void done(const Unit&) const {}
};


template <class Epi, class Sched, bool ALIGN_EPI = false, bool SP2 = false>
__device__ __forceinline__ void gemm_phase(PG8_LAS unsigned char* lds, const Gemm g, const Sched& S, const Epi& E) {
    const int tid = tid_fresh(), wid = __builtin_amdgcn_readfirstlane(tid >> 6), lane = tid & 63, wr = wid >> 2, wc = wid & 3, fr = lane & 15, fq = lane >> 4;
    const int K = g.K, nt = K / BK;
    unsigned voffA[2], voffB[2];
#pragma unroll
    for (int i = 0; i < 2; ++i) { int R, C; stage_rc(tid * 16 + i * 8192, R, C); const int Rb = Epi::PERM ? ((R & ~31) + perm32(R & 31)) : R;
        voffA[i] = (unsigned)(R * K + C) * 2u; voffB[i] = (unsigned)(Rb * K + C) * 2u; }
    const size_t kstep = (size_t)(BK * 2);
    const size_t hstep = (size_t)HALF * K * 2;
    const size_t tstep = 2 * hstep;
    const unsigned ldsw = (unsigned)wid * 1024u;
    const int aoff = lds_byte(wr * 64 + fr, fq * 8), boff = lds_byte(wc * 32 + fr, fq * 8);
#define PG8_SA(b, h) (((b) * 2 + (h)) * HTB)
#define PG8_SB(b, h) ((4 + (b) * 2 + (h)) * HTB)
#define PG8_STAGE(bufoff, gbase, voff) do { _Pragma("unroll") for (int _i = 0; _i < 2; ++_i) \
        __builtin_amdgcn_global_load_lds((const unsigned*)((const char*)(gbase) + (voff)[_i]), (PG8_LAS unsigned*)(lds + (bufoff) + ldsw + _i * 8192), 16, 0, 0); } while (0)
#define PG8_LDA(dst, b, h) do { _Pragma("unroll") for (int m = 0; m < 4; ++m) _Pragma("unroll") for (int k = 0; k < 2; ++k) dst[m][k] = *(const PG8_LAS bf16x8*)(lds + PG8_SA(b, h) + aoff + m * 2048 + k * 1024); } while (0)
#define PG8_LDB(dst, b, h) do { _Pragma("unroll") for (int n = 0; n < 2; ++n) _Pragma("unroll") for (int k = 0; k < 2; ++k) dst[n][k] = *(const PG8_LAS bf16x8*)(lds + PG8_SB(b, h) + boff + n * 2048 + k * 1024); } while (0)
#define PG8_MMA(ai, bj, At, Bt) do { __builtin_amdgcn_s_setprio(1); _Pragma("unroll") for (int m = 0; m < 4; ++m) _Pragma("unroll") for (int n = 0; n < 2; ++n) _Pragma("unroll") for (int k = 0; k < 2; ++k) \
        acc[ai][bj][m][n] = __builtin_amdgcn_mfma_f32_16x16x32_bf16(Bt[n][k], At[m][k], acc[ai][bj][m][n], 0, 0, 0); __builtin_amdgcn_s_setprio(0); } while (0)
#define PG8_WAIT_V(n) asm volatile("s_waitcnt vmcnt(" #n ")" ::: "memory")
#define PG8_WAIT_L(n) asm volatile("s_waitcnt lgkmcnt(" #n ")" ::: "memory")
#define PG8_BAR __builtin_amdgcn_s_barrier()
#define PG8_SCHED __builtin_amdgcn_sched_barrier(0)
    Unit cur, nxt; int ui = 0;
    if (!S.next(0, cur)) return;
    f32x4 acc[2][2][4][2];
#pragma unroll
    for (int a = 0; a < 2; ++a)
#pragma unroll
        for (int b = 0; b < 2; ++b)
#pragma unroll
            for (int m = 0; m < 4; ++m)
#pragma unroll
                for (int n = 0; n < 2; ++n) acc[a][b][m][n] = (f32x4){0.f, 0.f, 0.f, 0.f};
    bf16x8 At[4][2], B0[2][2], B1[2][2];
    const char* cA = (const char*)g.A + (size_t)cur.pm * tstep; const char* cB = (const char*)g.Bt + (size_t)cur.pn * tstep;
    S.a_ready(cur);
    if constexpr (SP2) {
        PG8_STAGE(PG8_SB(0, 0), cB, voffB); PG8_STAGE(PG8_SB(0, 1), cB + hstep, voffB); PG8_STAGE(PG8_SA(0, 0), cA, voffA); PG8_STAGE(PG8_SA(0, 1), cA + hstep, voffA);
        if (wr == 1) PG8_BAR;
        PG8_WAIT_V(2); PG8_BAR;
        PG8_STAGE(PG8_SB(1, 0), cB + kstep, voffB); PG8_STAGE(PG8_SA(1, 0), cA + kstep, voffA); PG8_STAGE(PG8_SB(1, 1), cB + hstep + kstep, voffB);
        PG8_WAIT_V(6); PG8_BAR;
    } else {
        PG8_STAGE(PG8_SB(0, 0), cB, voffB); PG8_STAGE(PG8_SA(0, 0), cA, voffA); PG8_STAGE(PG8_SB(0, 1), cB + hstep, voffB); PG8_STAGE(PG8_SA(0, 1), cA + hstep, voffA);
        if (wr == 1) PG8_BAR;
        PG8_WAIT_V(4); PG8_BAR;
        PG8_STAGE(PG8_SB(1, 0), cB + kstep, voffB); PG8_STAGE(PG8_SA(1, 0), cA + kstep, voffA); PG8_STAGE(PG8_SB(1, 1), cB + hstep + kstep, voffB);
        PG8_WAIT_V(6); PG8_BAR;
    }
    for (;;) {
        const bool has_next = S.next(ui + 1, nxt);
        const char* nA = has_next ? (const char*)g.A + (size_t)nxt.pm * tstep : cA; const char* nB = has_next ? (const char*)g.Bt + (size_t)nxt.pn * tstep : cB;
        for (int t = 0; t < nt; t += 2) {
            const bool last = (t == nt - 2);
            const char* a1 = cA + (size_t)(t + 1) * kstep;
            const char* a2 = last ? nA : cA + (size_t)(t + 2) * kstep; const char* b2 = last ? nB : cB + (size_t)(t + 2) * kstep;
            const char* a3 = a2 + kstep; const char* b3 = b2 + kstep;
            if (last && has_next) S.a_ready(nxt);
            if constexpr (SP2) {
            PG8_LDB(B0, 0, 0); PG8_LDB(B1, 0, 1); PG8_SCHED; PG8_LDA(At, 0, 0); PG8_STAGE(PG8_SA(1, 1), a1 + hstep, voffA);
            PG8_WAIT_V(8); PG8_WAIT_L(0); PG8_BAR; PG8_MMA(0, 0, At, B0); PG8_MMA(0, 1, At, B1); PG8_BAR; PG8_SCHED;
            PG8_LDA(At, 0, 1); PG8_STAGE(PG8_SB(0, 0), b2, voffB); PG8_STAGE(PG8_SB(0, 1), b2 + hstep, voffB); PG8_STAGE(PG8_SA(0, 0), a2, voffA);
            PG8_WAIT_V(8); PG8_WAIT_L(0); PG8_BAR; PG8_MMA(1, 0, At, B0); PG8_MMA(1, 1, At, B1); PG8_BAR; PG8_SCHED;
            PG8_LDB(B0, 1, 0); PG8_LDB(B1, 1, 1); PG8_SCHED; PG8_LDA(At, 1, 0); PG8_STAGE(PG8_SA(0, 1), a2 + hstep, voffA);
            PG8_WAIT_V(8); PG8_WAIT_L(0); PG8_BAR; PG8_MMA(0, 0, At, B0); PG8_MMA(0, 1, At, B1); PG8_BAR; PG8_SCHED;
            PG8_LDA(At, 1, 1); PG8_STAGE(PG8_SB(1, 0), b3, voffB); PG8_STAGE(PG8_SB(1, 1), b3 + hstep, voffB); PG8_STAGE(PG8_SA(1, 0), a3, voffA);
            PG8_WAIT_V(8); PG8_WAIT_L(0); PG8_BAR; PG8_MMA(1, 0, At, B0); PG8_MMA(1, 1, At, B1); PG8_BAR; PG8_SCHED;
            } else {
            PG8_LDB(B0, 0, 0); PG8_SCHED; PG8_LDA(At, 0, 0); PG8_STAGE(PG8_SA(1, 1), a1 + hstep, voffA);
            PG8_WAIT_L(8); PG8_BAR; PG8_WAIT_L(0); PG8_MMA(0, 0, At, B0); PG8_BAR; PG8_SCHED;
            PG8_LDB(B1, 0, 1); PG8_STAGE(PG8_SB(0, 0), b2, voffB);
            PG8_BAR; PG8_WAIT_L(0); PG8_MMA(0, 1, At, B1); PG8_BAR;
            PG8_LDA(At, 0, 1); PG8_STAGE(PG8_SA(0, 0), a2, voffA);
            PG8_BAR; PG8_WAIT_L(0); PG8_MMA(1, 0, At, B0); PG8_BAR; PG8_SCHED;
            PG8_STAGE(PG8_SB(0, 1), b2 + hstep, voffB);
            PG8_WAIT_V(6); PG8_BAR; PG8_MMA(1, 1, At, B1); PG8_BAR;
            PG8_LDB(B0, 1, 0); PG8_SCHED; PG8_LDA(At, 1, 0); PG8_STAGE(PG8_SA(0, 1), a2 + hstep, voffA);
            PG8_WAIT_L(8); PG8_BAR; PG8_WAIT_L(0); PG8_MMA(0, 0, At, B0); PG8_BAR; PG8_SCHED;
            PG8_LDB(B1, 1, 1); PG8_STAGE(PG8_SB(1, 0), b3, voffB);
            PG8_BAR; PG8_WAIT_L(0); PG8_MMA(0, 1, At, B1); PG8_BAR;
            PG8_LDA(At, 1, 1); PG8_STAGE(PG8_SA(1, 0), a3, voffA);
            PG8_BAR; PG8_WAIT_L(0); PG8_MMA(1, 0, At, B0); PG8_BAR; PG8_SCHED;
            PG8_STAGE(PG8_SB(1, 1), b3 + hstep, voffB);
            PG8_WAIT_V(6); PG8_BAR; PG8_MMA(1, 1, At, B1); PG8_BAR;
            }
        }
        if constexpr (ALIGN_EPI) { if (wr == 0) PG8_BAR; }
        if constexpr (!Epi::AFTER_DRAIN) { E(acc, cur, wr, wc, fr, fq); S.done(cur); }
        if (!has_next) break;
#pragma unroll
        for (int a = 0; a < 2; ++a)
#pragma unroll
            for (int b = 0; b < 2; ++b)
#pragma unroll
                for (int m = 0; m < 4; ++m)
#pragma unroll
                    for (int n = 0; n < 2; ++n) acc[a][b][m][n] = (f32x4){0.f, 0.f, 0.f, 0.f};
        cur = nxt; cA = nA; cB = nB; ++ui;
        if constexpr (ALIGN_EPI) { if (wr == 1) PG8_BAR; }
    }
    PG8_WAIT_V(0);
    if constexpr (!ALIGN_EPI) { if (wr == 0) PG8_BAR; }
    PG8_BAR;
    if constexpr (Epi::AFTER_DRAIN) { E.fused(acc, cur, wr, wc, fr, fq, lds, wid, lane); S.done(cur); }
#undef PG8_SA
#undef PG8_SB
#undef PG8_STAGE
#undef PG8_LDA
#undef PG8_LDB
#undef PG8_MMA
#undef PG8_WAIT_V
#undef PG8_WAIT_L
#undef PG8_BAR
#undef PG8_SCHED
}
}

enum { EPI_INPROJ = 0, EPI_RES = 1, EPI_SWIGLU = 2, EPI_F32 = 3, EPI_KV = 4, EPI_BF16 = 5 };
template <int MODE> struct Epi {
    static constexpr bool PERM = (MODE != EPI_RES && MODE != EPI_F32), AFTER_DRAIN = false;
    const float* res; float* outf; int ldo; bf16_t* o0; bf16_t* o1; bf16_t* o2;
    DI void operator()(const f32x4 (&acc)[2][2][4][2], const pg8::Unit& u, int wr, int wc, int fr, int fq) const {
#pragma unroll
        for (int ai = 0; ai < 2; ++ai)
#pragma unroll
            for (int m = 0; m < 4; ++m) {
                const int r = u.pm * 256 + ai * 128 + wr * 64 + m * 16 + fr;
                if (MODE == EPI_SWIGLU) {
                    const f32x4 g0 = acc[ai][0][m][0], g1 = acc[ai][0][m][1], u0 = acc[ai][1][m][0], u1 = acc[ai][1][m][1];
#define SWG(g, u) nopack(nopack(siluf(nopack(g))) * (u))
                    u32x4 w; w.x = pack2(SWG(g0[0], u0[0]), SWG(g0[1], u0[1])); w.y = pack2(SWG(g0[2], u0[2]), SWG(g0[3], u0[3]));
                    w.z = pack2(SWG(g1[0], u1[0]), SWG(g1[1], u1[1])); w.w = pack2(SWG(g1[2], u1[2]), SWG(g1[3], u1[3]));
#undef SWG
                    *(u32x4*)(o0 + (size_t)r * 2816 + u.pn * 128 + wc * 32 + fq * 8) = w;
                } else {
#pragma unroll
                    for (int bj = 0; bj < 2; ++bj) {
                        if (!PERM) {
#pragma unroll
                            for (int n = 0; n < 2; ++n) {
                                const int c = u.pn * 256 + bj * 128 + wc * 32 + n * 16 + fq * 4; const f32x4 a = acc[ai][bj][m][n];
                                if (MODE == EPI_RES) { const size_t off = (size_t)r * 1024 + c; const f32x4 rv = *(const f32x4*)(res + off); *(f32x4*)(outf + off) = rv + a; }
                                else { *(f32x4*)(outf + (size_t)r * ldo + c) = a; }
                            }
                        } else {
                            const int cl = bj * 128 + wc * 32 + fq * 8; const int c = u.pn * 256 + cl; const f32x4 a0 = acc[ai][bj][m][0], a1 = acc[ai][bj][m][1];
                            if (MODE == EPI_INPROJ) {
                                if (u.pn < 4) { u32x4 w; w.x = pack2(a0[0], a0[1]); w.y = pack2(a0[2], a0[3]); w.z = pack2(a1[0], a1[1]); w.w = pack2(a1[2], a1[3]); *(u32x4*)(o0 + (size_t)r * 1024 + c) = w; }
                                else if (u.pn < 8) { const int h = u.pn - 4, ch = r >> 6, jx = r & 63; bf16_t* vp = o1 + ((size_t)(ch * 4 + h) * 256 + cl) * 64 + jx;
#pragma unroll
                                    for (int e = 0; e < 4; ++e) { vp[e * 64] = f2bf(a0[e]); vp[(e + 4) * 64] = f2bf(a1[e]); } }
                                else { u32x4 w; w.x = pack2(nopack(siluf(nopack(a0[0]))), nopack(siluf(nopack(a0[1])))); w.y = pack2(nopack(siluf(nopack(a0[2]))), nopack(siluf(nopack(a0[3])))); w.z = pack2(nopack(siluf(nopack(a1[0]))), nopack(siluf(nopack(a1[1])))); w.w = pack2(nopack(siluf(nopack(a1[2]))), nopack(siluf(nopack(a1[3]))));
                                    *(u32x4*)(o2 + (size_t)r * 1024 + (c - 2048)) = w; }
                            } else if (MODE == EPI_KV) {
                                const int head = u.pn * 2 + bj, hc = wc * 32 + fq * 8;
                                if (wc < 2) { u32x4 w; w.x = pack2(a0[0], a0[1]); w.y = pack2(a0[2], a0[3]); w.z = pack2(a1[0], a1[1]); w.w = pack2(a1[2], a1[3]); *(u32x4*)(o0 + ((size_t)r * 16 + head) * 96 + hc) = w; }
                                else { bf16_t* vp = o1 + ((size_t)head * 64 + (hc - 64)) * S + r;
#pragma unroll
                                    for (int e = 0; e < 4; ++e) { vp[(size_t)e * S] = f2bf(a0[e]); vp[(size_t)(e + 4) * S] = f2bf(a1[e]); } }
                            } else {
                                u32x4 w; w.x = pack2(a0[0], a0[1]); w.y = pack2(a0[2], a0[3]); w.z = pack2(a1[0], a1[1]); w.w = pack2(a1[2], a1[3]); *(u32x4*)(o0 + (size_t)r * ldo + c) = w;
                            }
                        }
                    }
                }
                asm volatile("" ::: "memory");
            }
    }
};
template <int MODE>
DI void gemm_phase(const bf16_t* A, const bf16_t* Bt, int N, int K, const Epi<MODE>& E, char* smem) {
    asm volatile("" : "+s"(K));
    pg8::Gemm g{A, Bt, S, N, K}; pg8::StaticOrder so; so.init(S, N, (int)gridDim.x, (int)blockIdx.x);
    pg8::gemm_phase<Epi<MODE>, pg8::StaticOrder, true, true>((PG8_LAS unsigned char*)smem, g, so, E);
}

struct EpiResNorm {
    static constexpr bool PERM = false, AFTER_DRAIN = true;
    const float* res; float* outf; bf16_t* xh; float* xbuf; unsigned* cnt;
    DI void operator()(const f32x4 (&)[2][2][4][2], const pg8::Unit&, int, int, int, int) const {}
    DI void fused(f32x4 (&acc)[2][2][4][2], const pg8::Unit& u, int wr, int wc, int fr, int fq, PG8_LAS unsigned char* lds, int wid, int lane) const {
        PG8_LAS float* P = (PG8_LAS float*)lds; PG8_LAS float* Sr = (PG8_LAS float*)(lds + 4096);
        const int tid = wid * 64 + lane;
#pragma unroll
        for (int ai = 0; ai < 2; ++ai)
#pragma unroll
            for (int m = 0; m < 4; ++m) {
                const int rl = ai * 128 + wr * 64 + m * 16 + fr; const size_t rowoff = (size_t)(u.pm * 256 + rl) * 1024 + u.pn * 256 + wc * 32 + fq * 4; float ss = 0.f;
#pragma unroll
                for (int bj = 0; bj < 2; ++bj)
#pragma unroll
                    for (int n = 0; n < 2; ++n) { const f32x4 v = *(const f32x4*)(res + rowoff + bj * 128 + n * 16) + acc[ai][bj][m][n]; acc[ai][bj][m][n] = v; ss += v[0] * v[0] + v[1] * v[1] + v[2] * v[2] + v[3] * v[3]; }
                ss += __shfl_xor(ss, 16); ss += __shfl_xor(ss, 32);
                if (fq == 0) P[rl * 4 + wc] = ss;
                asm volatile("" ::: "memory");
            }
        __syncthreads();
        if (tid < 256) {
            const float tot = (P[tid * 4] + P[tid * 4 + 1]) + (P[tid * 4 + 2] + P[tid * 4 + 3]);
            __hip_atomic_store(xbuf + (size_t)(u.pm * 256 + tid) * 4 + u.pn, tot, __ATOMIC_RELAXED, __HIP_MEMORY_SCOPE_AGENT);
            asm volatile("s_waitcnt vmcnt(0)" ::: "memory");
            if (lane == 0) __hip_atomic_fetch_add(cnt + 64 * u.pm, 1u, __ATOMIC_RELAXED, __HIP_MEMORY_SCOPE_AGENT);
        }
        if (wid == 0) {
            unsigned sp = 0u;
            while (__hip_atomic_load(cnt + 64 * u.pm, __ATOMIC_RELAXED, __HIP_MEMORY_SCOPE_AGENT) < 16u) { __builtin_amdgcn_s_sleep(1); if (++sp > (1u << 22)) break; }
            __builtin_amdgcn_fence(__ATOMIC_ACQUIRE, "agent");
            asm volatile("s_waitcnt vmcnt(0)" ::: "memory");
        }
        __syncthreads();
        if (tid < 256) {
            const float* sl = xbuf + (size_t)(u.pm * 256 + tid) * 4;
            const float t = (__hip_atomic_load(sl, __ATOMIC_RELAXED, __HIP_MEMORY_SCOPE_AGENT) + __hip_atomic_load(sl + 1, __ATOMIC_RELAXED, __HIP_MEMORY_SCOPE_AGENT))
                          + (__hip_atomic_load(sl + 2, __ATOMIC_RELAXED, __HIP_MEMORY_SCOPE_AGENT) + __hip_atomic_load(sl + 3, __ATOMIC_RELAXED, __HIP_MEMORY_SCOPE_AGENT));
            Sr[tid] = rsqrtf(t * (1.f / 1024.f) + EPS);
        }
        __syncthreads();
#pragma unroll
        for (int ai = 0; ai < 2; ++ai)
#pragma unroll
            for (int m = 0; m < 4; ++m) {
                const int rl = ai * 128 + wr * 64 + m * 16 + fr; const size_t rowoff = (size_t)(u.pm * 256 + rl) * 1024 + u.pn * 256 + wc * 32 + fq * 4; const float rstd = Sr[rl];
#pragma unroll
                for (int bj = 0; bj < 2; ++bj)
#pragma unroll
                    for (int n = 0; n < 2; ++n) { const f32x4 v = acc[ai][bj][m][n]; const size_t off = rowoff + bj * 128 + n * 16; *(f32x4*)(outf + off) = v;
                        u32x2 w; w.x = pack2(v[0] * rstd, v[1] * rstd); w.y = pack2(v[2] * rstd, v[3] * rstd); *(u32x2*)(xh + off) = w; }
                asm volatile("" ::: "memory");
            }
    }
};
struct EpiLatent {
    static constexpr bool PERM = false, AFTER_DRAIN = true;
    bf16_t* ckv; bf16_t* cq; float* krope; float* xbuf; unsigned* cnt; const float* ropet; const float* kgain; float* krss;
    DI void operator()(const f32x4 (&)[2][2][4][2], const pg8::Unit&, int, int, int, int) const {}
    DI void fused(f32x4 (&acc)[2][2][4][2], const pg8::Unit& u, int wr, int wc, int fr, int fq, PG8_LAS unsigned char* lds, int wid, int lane) const {
        PG8_LAS float* P = (PG8_LAS float*)lds; PG8_LAS float* Sr = (PG8_LAS float*)(lds + 4096);
        const int tid = wid * 64 + lane;
#pragma unroll
        for (int ai = 0; ai < 2; ++ai)
#pragma unroll
            for (int m = 0; m < 4; ++m) {
                const int rl = ai * 128 + wr * 64 + m * 16 + fr; float ss = 0.f;
#pragma unroll
                for (int bj = 0; bj < 2; ++bj)
#pragma unroll
                    for (int n = 0; n < 2; ++n) { const f32x4 v = acc[ai][bj][m][n]; const float q = v[0] * v[0] + v[1] * v[1] + v[2] * v[2] + v[3] * v[3]; if (bj == 0 || u.pn != 2) ss += q; }
                ss += __shfl_xor(ss, 16); ss += __shfl_xor(ss, 32);
                if (fq == 0) P[rl * 4 + wc] = ss;
            }
        __syncthreads();
        if (u.pn != 0) {
            if (tid < 256) {
                const float tot = (P[tid * 4] + P[tid * 4 + 1]) + (P[tid * 4 + 2] + P[tid * 4 + 3]);
                __hip_atomic_store(xbuf + (size_t)(u.pm * 256 + tid) * 2 + (u.pn - 1), tot, __ATOMIC_RELAXED, __HIP_MEMORY_SCOPE_AGENT);
                asm volatile("s_waitcnt vmcnt(0)" ::: "memory");
                if (lane == 0) __hip_atomic_fetch_add(cnt + 64 * u.pm, 1u, __ATOMIC_RELAXED, __HIP_MEMORY_SCOPE_AGENT);
            }
            if (wid == 0) {
                unsigned sp = 0u;
                while (__hip_atomic_load(cnt + 64 * u.pm, __ATOMIC_RELAXED, __HIP_MEMORY_SCOPE_AGENT) < 8u) { __builtin_amdgcn_s_sleep(1); if (++sp > (1u << 22)) break; }
                __builtin_amdgcn_fence(__ATOMIC_ACQUIRE, "agent");
                asm volatile("s_waitcnt vmcnt(0)" ::: "memory");
            }
            __syncthreads();
            if (tid < 256) {
                const float* sl = xbuf + (size_t)(u.pm * 256 + tid) * 2;
                const float t = __hip_atomic_load(sl, __ATOMIC_RELAXED, __HIP_MEMORY_SCOPE_AGENT) + __hip_atomic_load(sl + 1, __ATOMIC_RELAXED, __HIP_MEMORY_SCOPE_AGENT);
                Sr[tid] = rsqrtf(t * (1.f / 384.f) + EPS);
            }
        } else {
            if (tid < 256) Sr[tid] = rsqrtf(((P[tid * 4] + P[tid * 4 + 1]) + (P[tid * 4 + 2] + P[tid * 4 + 3])) * (1.f / 256.f) + EPS);
        }
        __syncthreads();
#pragma unroll
        for (int ai = 0; ai < 2; ++ai)
#pragma unroll
            for (int m = 0; m < 4; ++m) {
                const int rl = ai * 128 + wr * 64 + m * 16 + fr; const size_t r = (size_t)(u.pm * 256 + rl); const float rstd = Sr[rl];
#pragma unroll
                for (int bj = 0; bj < 2; ++bj)
#pragma unroll
                    for (int n = 0; n < 2; ++n) {
                        const f32x4 v = acc[ai][bj][m][n]; const int cl = bj * 128 + wc * 32 + n * 16 + fq * 4;
                        u32x2 w; w.x = pack2(v[0] * rstd, v[1] * rstd); w.y = pack2(v[2] * rstd, v[3] * rstd);
                        if (u.pn == 0) *(u32x2*)(ckv + r * 256 + cl) = w;
                        else if (u.pn == 1) *(u32x2*)(cq + r * 384 + cl) = w;
                        else if (bj == 0) *(u32x2*)(cq + r * 384 + 256 + cl) = w;
                    }
                if (u.pn == 2 && wc == 0) {
                    const f32x4 v0 = acc[ai][1][m][0], v1 = acc[ai][1][m][1];
                    float q = (v0[0] * v0[0] + v0[1] * v0[1] + v0[2] * v0[2] + v0[3] * v0[3]) + (v1[0] * v1[0] + v1[1] * v1[1] + v1[2] * v1[2] + v1[3] * v1[3]);
                    q += __shfl_xor(q, 16); q += __shfl_xor(q, 32);
                    if (fq == 0) krss[r] = q;
                    const f32x4 g1 = *(const f32x4*)(kgain + 64 + 4 * fq), g2 = *(const f32x4*)(kgain + 80 + 4 * fq);
                    const f32x4 cs = *(const f32x4*)(ropet + r * 32 + 4 * fq), sn = *(const f32x4*)(ropet + r * 32 + 16 + 4 * fq);
                    const f32x4 x1 = v0 * g1, x2 = v1 * g2;
                    *(f32x4*)(krope + r * 32 + 4 * fq) = x1 * cs - x2 * sn; *(f32x4*)(krope + r * 32 + 16 + 4 * fq) = x1 * sn + x2 * cs;
                }
                asm volatile("" ::: "memory");
            }
    }
};
DI void gemm_phase_latent(const bf16_t* A, const bf16_t* Bt, const EpiLatent& E, char* smem) {
    int K = 1024; asm volatile("" : "+s"(K));
    pg8::Gemm g{A, Bt, S, 768, K}; pg8::StaticOrder so; so.init(S, 768, (int)gridDim.x, (int)blockIdx.x);
    pg8::gemm_phase<EpiLatent, pg8::StaticOrder, false, true>((PG8_LAS unsigned char*)smem, g, so, E);
}
struct EpiKV2 {
    static constexpr bool PERM = true, AFTER_DRAIN = false;
    bf16_t* kb; bf16_t* vt; const float* krss; const float* krope;
    DI void operator()(const f32x4 (&acc)[2][2][4][2], const pg8::Unit& u, int wr, int wc, int fr, int fq) const {
        const int head = u.pn * 2 + (wc >> 1);
#pragma unroll
        for (int ai = 0; ai < 2; ++ai)
#pragma unroll
            for (int m = 0; m < 4; ++m) {
                const int r = u.pm * 256 + ai * 128 + wr * 64 + m * 16 + fr;
                if ((wc & 1) == 0) {
                    float ss = 0.f;
#pragma unroll
                    for (int bj = 0; bj < 2; ++bj)
#pragma unroll
                        for (int n = 0; n < 2; ++n) { const f32x4 v = acc[ai][bj][m][n]; ss += v[0] * v[0] + v[1] * v[1] + v[2] * v[2] + v[3] * v[3]; }
                    ss += __shfl_xor(ss, 16); ss += __shfl_xor(ss, 32);
                    const float rstd = rsqrtf((ss + krss[r]) * (1.f / 96.f) + EPS);
                    bf16_t* kp = kb + ((size_t)r * 16 + head) * 96;
#pragma unroll
                    for (int bj = 0; bj < 2; ++bj) { const f32x4 a0 = acc[ai][bj][m][0] * rstd, a1 = acc[ai][bj][m][1] * rstd;
                        u32x4 w; w.x = pack2(a0[0], a0[1]); w.y = pack2(a0[2], a0[3]); w.z = pack2(a1[0], a1[1]); w.w = pack2(a1[2], a1[3]); *(u32x4*)(kp + bj * 32 + fq * 8) = w; }
                    const f32x4 k0 = *(const f32x4*)(krope + (size_t)r * 32 + fq * 8) * rstd, k1 = *(const f32x4*)(krope + (size_t)r * 32 + fq * 8 + 4) * rstd;
                    u32x4 w; w.x = pack2(k0[0], k0[1]); w.y = pack2(k0[2], k0[3]); w.z = pack2(k1[0], k1[1]); w.w = pack2(k1[2], k1[3]); *(u32x4*)(kp + 64 + fq * 8) = w;
                } else {
#pragma unroll
                    for (int bj = 0; bj < 2; ++bj) { const f32x4 a0 = acc[ai][bj][m][0], a1 = acc[ai][bj][m][1]; bf16_t* vp = vt + ((size_t)head * 64 + bj * 32 + fq * 8) * S + r;
#pragma unroll
                        for (int e = 0; e < 4; ++e) { vp[(size_t)e * S] = f2bf(a0[e]); vp[(size_t)(e + 4) * S] = f2bf(a1[e]); } }
                }
                asm volatile("" ::: "memory");
            }
    }
};
DI void gemm_phase_kv2(const bf16_t* A, const bf16_t* Bt, const EpiKV2& E, char* smem) {
    int K = 256; asm volatile("" : "+s"(K));
    pg8::Gemm g{A, Bt, S, 2048, K}; pg8::StaticOrder so; so.init(S, 2048, (int)gridDim.x, (int)blockIdx.x);
    pg8::gemm_phase<EpiKV2, pg8::StaticOrder, true, true>((PG8_LAS unsigned char*)smem, g, so, E);
}
DI void gemm_phase_resnorm(const bf16_t* A, const bf16_t* Bt, int K, const EpiResNorm& E, char* smem) {
    asm volatile("" : "+s"(K));
    pg8::Gemm g{A, Bt, S, 1024, K}; pg8::StaticOrder so; so.init(S, 1024, (int)gridDim.x, (int)blockIdx.x);
    pg8::gemm_phase<EpiResNorm, pg8::StaticOrder, false, true>((PG8_LAS unsigned char*)smem, g, so, E);
}

DI void gla_gate(const Params& p, int n, int h, float* gl_s, float* tot_s, float (&bcum)[32], float& blast) {
    const int tid = tid_fresh() & 255, c = tid & 127, hf = tid >> 7;
    const float* glp = (const float*)(p.ws + GL) + (size_t)n * 64 * 16;
    *(f32x4*)(gl_s + tid * 4) = *(const f32x4*)(glp + tid * 4);
    float wgu[16];
#pragma unroll
    for (int r = 0; r < 16; ++r) wgu[r] = p.a_w_gate_up[r * 512 + h * 128 + c];
    const float bias = p.a_b_gate[h * 128 + c];
    __syncthreads();
    float cum = 0.f;
#pragma unroll
    for (int i = 0; i < 32; ++i) {
        const f32x4* gr = (const f32x4*)(gl_s + (hf * 32 + i) * 16); float z = bias;
#pragma unroll
        for (int r4 = 0; r4 < 4; ++r4) { const f32x4 g = gr[r4];
#pragma unroll
            for (int e = 0; e < 4; ++e) { z = __builtin_fmaf(g[e], wgu[r4 * 4 + e], z); asm("" : "+v"(z)); } }
        const float ls = fminf(z, 0.f) - __logf(1.f + __expf(-fabsf(z)));
        cum += ls * (1.f / 16.f); bcum[i] = cum;
    }
    tot_s[hf * 128 + c] = cum;
    __syncthreads();
    const float t0 = tot_s[c], t1 = tot_s[128 + c];
    if (hf) {
#pragma unroll
        for (int i = 0; i < 32; ++i) bcum[i] += t0;
    }
    blast = t0 + t1;
}

DI void gla_kv_unit(const Params& p, int u, char* smem) {
    float* gl_s = (float*)smem; float* tot_s = gl_s + 1024; bf16_t* kend_s = (bf16_t*)(tot_s + 256);
    const int tid = tid_fresh() & 255, c = tid & 127, hf = tid >> 7, lane = tid & 63, w = tid >> 6, lr = lane & 15, lq = lane >> 4;
    const int n = u >> 2, h = u & 3;
    float bcum[32], blast; gla_gate(p, n, h, gl_s, tot_s, bcum, blast);
    const bf16_t* kp = (const bf16_t*)(p.ws + QK) + (size_t)(n * 64 + hf * 32) * 1024 + 512 + h * 128 + c;
    unsigned pk[16];
#pragma unroll
    for (int i = 0; i < 32; i += 2) {
        const float k0 = bf2f(kp[(size_t)i * 1024]), k1 = bf2f(kp[(size_t)(i + 1) * 1024]);
        pk[i >> 1] = pack2(k0 * __expf(blast - bcum[i]), k1 * __expf(blast - bcum[i + 1]));
    }
    u32x4* dst = (u32x4*)(kend_s + c * 72 + hf * 32);
#pragma unroll
    for (int i = 0; i < 4; ++i) dst[i] = (u32x4){pk[4 * i], pk[4 * i + 1], pk[4 * i + 2], pk[4 * i + 3]};
    if (hf == 0) ((float*)(p.ws + DEC))[(size_t)u * 128 + c] = __expf(blast);
    __syncthreads();
    const int dv0 = w * 64;
    const bf16_t* vt = (const bf16_t*)(p.ws + VT) + ((size_t)u * 256 + dv0) * 64;
    bf16x8 vf[4][2];
#pragma unroll
    for (int mt = 0; mt < 4; ++mt)
#pragma unroll
        for (int kk = 0; kk < 2; ++kk) vf[mt][kk] = *(const bf16x8*)(vt + (mt * 16 + lr) * 64 + kk * 32 + lq * 8);
    bf16_t* kvo = (bf16_t*)(p.ws + KVT) + (size_t)u * 256 * 128;
#pragma unroll
    for (int half = 0; half < 2; ++half) {
        f32x4 acc[4][4];
#pragma unroll
        for (int a = 0; a < 4; ++a)
#pragma unroll
            for (int b = 0; b < 4; ++b) acc[a][b] = (f32x4){0.f, 0.f, 0.f, 0.f};
#pragma unroll
        for (int kk = 0; kk < 2; ++kk)
#pragma unroll
            for (int nt = 0; nt < 4; ++nt) {
                const bf16x8 kf = *(const bf16x8*)(kend_s + ((half * 4 + nt) * 16 + lr) * 72 + kk * 32 + lq * 8);
#pragma unroll
                for (int mt = 0; mt < 4; ++mt) acc[nt][mt] = mfma16(kf, vf[mt][kk], acc[nt][mt]);
            }
#pragma unroll
        for (int nt = 0; nt < 4; ++nt)
#pragma unroll
            for (int mt = 0; mt < 4; ++mt) {
                const int dk = (half * 4 + nt) * 16 + lq * 4, dv = dv0 + mt * 16 + lr; const f32x4 a = acc[nt][mt];
                u32x2 wv; wv.x = pack2(a[0], a[1]); wv.y = pack2(a[2], a[3]); *(u32x2*)(kvo + (size_t)dv * 128 + dk) = wv;
            }
    }
    __syncthreads();
}

DI void gla_scan(const Params& p) {
    const int gt = blockIdx.x * NT + tid_fresh(), nth = gridDim.x * NT;
    for (int e = gt; e < 131072; e += nth) {
        const int h = e >> 15, dk = e & 127;
        bf16_t* kv = (bf16_t*)(p.ws + KVT) + e; const float* dec = (const float*)(p.ws + DEC) + h * 128 + dk;
        float s0 = 0.f;
        for (int n = 0; n < 256; n += 16) {
            bf16_t v[16]; float d[16];
#pragma unroll
            for (int q = 0; q < 16; ++q) { v[q] = kv[(size_t)(n + q) * 131072]; d[q] = dec[(size_t)(n + q) * 512]; }
#pragma unroll
            for (int q = 0; q < 16; ++q) { kv[(size_t)(n + q) * 131072] = f2bf(s0); s0 = d[q] * s0 + bf2f(v[q]); }
        }
    }
}

DI void gla_out_unit(const Params& p, int u, char* smem) {
    float* gl_s = (float*)smem; float* tot_s = gl_s + 1024; float* ss_s = tot_s + 256; bf16_t* qdec_s = (bf16_t*)(ss_s + 256);
    bf16_t* kinv_s = qdec_s + 64 * 136; bf16_t* attn_s = kinv_s + 64 * 136;
    const int tid = tid_fresh() & 255, c = tid & 127, hf = tid >> 7, lane = tid & 63, w = tid >> 6, lr = lane & 15, lq = lane >> 4;
    const int n = u >> 2, h = u & 3;
    float bcum[32], blast; gla_gate(p, n, h, gl_s, tot_s, bcum, blast);
    {
        const bf16_t* qp = (const bf16_t*)(p.ws + QK) + (size_t)(n * 64 + hf * 32) * 1024 + h * 128 + c;
#pragma unroll
        for (int i = 0; i < 32; ++i) {
            const float q = bf2f(qp[(size_t)i * 1024]), k = bf2f(qp[(size_t)i * 1024 + 512]);
            const int row = hf * 32 + i;
            qdec_s[row * 136 + c] = f2bf(q * 0.08838834764831845f * __expf(bcum[i]));
            kinv_s[row * 136 + c] = f2bf(k * __expf(-bcum[i]));
        }
    }
    __syncthreads();
    {
        bf16x8 qf[4];
#pragma unroll
        for (int kk = 0; kk < 4; ++kk) qf[kk] = *(const bf16x8*)(qdec_s + (w * 16 + lr) * 136 + kk * 32 + lq * 8);
#pragma unroll
        for (int jt = 0; jt < 4; ++jt) {
            f32x4 a = (f32x4){0.f, 0.f, 0.f, 0.f};
            if (jt <= w) {
#pragma unroll
                for (int kk = 0; kk < 4; ++kk) { const bf16x8 kf = *(const bf16x8*)(kinv_s + (jt * 16 + lr) * 136 + kk * 32 + lq * 8); a = mfma16(kf, qf[kk], a); }
            }
            const int i = w * 16 + lr, j0 = jt * 16 + lq * 4;
#pragma unroll
            for (int jj = 0; jj < 4; ++jj) if (j0 + jj > i) a[jj] = 0.f;
            u32x2 wv; wv.x = pack2(a[0], a[1]); wv.y = pack2(a[2], a[3]); *(u32x2*)(attn_s + i * 72 + j0) = wv;
        }
    }
    __syncthreads();
    f32x4 acc[4][4];
#pragma unroll
    for (int a = 0; a < 4; ++a)
#pragma unroll
        for (int b = 0; b < 4; ++b) acc[a][b] = (f32x4){0.f, 0.f, 0.f, 0.f};
    const int dv0 = w * 64;
    {
        const bf16_t* vt = (const bf16_t*)(p.ws + VT) + ((size_t)u * 256 + dv0) * 64;
#pragma unroll
        for (int kk = 0; kk < 2; ++kk) {
            bf16x8 af[4];
#pragma unroll
            for (int it = 0; it < 4; ++it) af[it] = *(const bf16x8*)(attn_s + (it * 16 + lr) * 72 + kk * 32 + lq * 8);
#pragma unroll
            for (int dt = 0; dt < 4; ++dt) { const bf16x8 vf = *(const bf16x8*)(vt + (dt * 16 + lr) * 64 + kk * 32 + lq * 8);
#pragma unroll
                for (int it = 0; it < 4; ++it) acc[dt][it] = mfma16(vf, af[it], acc[dt][it]); }
        }
        const bf16_t* sp = (const bf16_t*)(p.ws + KVT) + ((size_t)u * 256 + dv0) * 128;
#pragma unroll
        for (int kk = 0; kk < 4; ++kk) {
            bf16x8 qf[4];
#pragma unroll
            for (int it = 0; it < 4; ++it) qf[it] = *(const bf16x8*)(qdec_s + (it * 16 + lr) * 136 + kk * 32 + lq * 8);
#pragma unroll
            for (int dt = 0; dt < 4; ++dt) { const bf16x8 sf = *(const bf16x8*)(sp + (dt * 16 + lr) * 128 + kk * 32 + lq * 8);
#pragma unroll
                for (int it = 0; it < 4; ++it) acc[dt][it] = mfma16(sf, qf[it], acc[dt][it]); }
        }
    }
#pragma unroll
    for (int it = 0; it < 4; ++it) {
        float ss = 0.f;
#pragma unroll
        for (int dt = 0; dt < 4; ++dt) { const f32x4 a = acc[dt][it]; ss += a[0] * a[0] + a[1] * a[1] + a[2] * a[2] + a[3] * a[3]; }
        ss += __shfl_xor(ss, 16); ss += __shfl_xor(ss, 32);
        if (lq == 0) ss_s[w * 64 + it * 16 + lr] = ss;
    }
    __syncthreads();
    const bf16_t* rb = (const bf16_t*)(p.ws + RB); bf16_t* og = (bf16_t*)(p.ws + XH);
#pragma unroll
    for (int it = 0; it < 4; ++it) {
        const int i = it * 16 + lr; const float tot = ss_s[i] + ss_s[64 + i] + ss_s[128 + i] + ss_s[192 + i];
        const float rstd = rsqrtf(tot * (1.f / 256.f) + EPS);
        const size_t rowoff = (size_t)(n * 64 + i) * 1024 + h * 256;
#pragma unroll
        for (int dt = 0; dt < 4; ++dt) {
            const int dv = dv0 + dt * 16 + lq * 4; const f32x4 gn = *(const f32x4*)(p.a_out_norm + dv); const u32x2 rr = *(const u32x2*)(rb + rowoff + dv); const f32x4 a = acc[dt][it];
            u32x2 wv; wv.x = pack2(a[0] * rstd * gn[0] * bflo(rr.x), a[1] * rstd * gn[1] * bfhi(rr.x)); wv.y = pack2(a[2] * rstd * gn[2] * bflo(rr.y), a[3] * rstd * gn[3] * bfhi(rr.y));
            *(u32x2*)(og + rowoff + dv) = wv;
        }
    }
    __syncthreads();
}

DI void latent_norm_phase(const Params& p) {
    const int tidf = tid_fresh(); const int lane = tidf & 63; const int gw = (blockIdx.x * NT + tidf) >> 6, nw = (gridDim.x * NT) >> 6;
    for (int s = gw; s < S; s += nw) {
        const float* d = (const float*)(p.ws + DBUF) + (size_t)s * 768;
        const f32x4 a = *(const f32x4*)(d + lane * 4);
        f32x2 b[3];
#pragma unroll
        for (int i = 0; i < 3; ++i) b[i] = *(const f32x2*)(d + 256 + i * 128 + lane * 2);
        float kr = 0.f; if (lane < 32) kr = d[640 + lane];
        float s1 = a[0] * a[0] + a[1] * a[1] + a[2] * a[2] + a[3] * a[3];
        float s2 = b[0].x * b[0].x + b[0].y * b[0].y + b[1].x * b[1].x + b[1].y * b[1].y + b[2].x * b[2].x + b[2].y * b[2].y;
#pragma unroll
        for (int o = 32; o >= 1; o >>= 1) { s1 += __shfl_xor(s1, o); s2 += __shfl_xor(s2, o); }
        const float r1 = rsqrtf(s1 * (1.f / 256.f) + EPS), r2 = rsqrtf(s2 * (1.f / 384.f) + EPS);
        u32x2 wv; wv.x = pack2(a[0] * r1, a[1] * r1); wv.y = pack2(a[2] * r1, a[3] * r1);
        *(u32x2*)((bf16_t*)(p.ws + CKV) + (size_t)s * 256 + lane * 4) = wv;
#pragma unroll
        for (int i = 0; i < 3; ++i) *(unsigned*)((bf16_t*)(p.ws + CQ) + (size_t)s * 384 + i * 128 + lane * 2) = pack2(b[i].x * r2, b[i].y * r2);
        if (lane < 32) ((float*)(p.ws + KROPE))[(size_t)s * 32 + lane] = kr;
    }
}

DI void qk_post_phase(const Params& p) {
    const int gt = blockIdx.x * NT + tid_fresh(), nth = gridDim.x * NT;
    for (int idx = gt; idx < 2 * S * 16; idx += nth) {
        const int isk = idx >= S * 16; const int id = isk ? idx - S * 16 : idx; const int s = id >> 4;
        bf16_t* vp = (bf16_t*)(p.ws + (isk ? KB : QB)) + (size_t)id * 96;
        const float* gain = isk ? p.k_norm : p.b_q_norm;
        float v[96];
#pragma unroll
        for (int i = 0; i < 8; ++i) { const u32x4 t = *(const u32x4*)(vp + i * 8);
            v[i * 8 + 0] = bflo(t.x); v[i * 8 + 1] = bfhi(t.x); v[i * 8 + 2] = bflo(t.y); v[i * 8 + 3] = bfhi(t.y); v[i * 8 + 4] = bflo(t.z); v[i * 8 + 5] = bfhi(t.z); v[i * 8 + 6] = bflo(t.w); v[i * 8 + 7] = bfhi(t.w); }
        if (isk) {
            const float* kr = (const float*)(p.ws + KROPE) + (size_t)s * 32;
#pragma unroll
            for (int i = 0; i < 8; ++i) { const f32x4 t = *(const f32x4*)(kr + i * 4); v[64 + i * 4] = t[0]; v[65 + i * 4] = t[1]; v[66 + i * 4] = t[2]; v[67 + i * 4] = t[3]; }
        } else {
#pragma unroll
            for (int i = 8; i < 12; ++i) { const u32x4 t = *(const u32x4*)(vp + i * 8);
                v[i * 8 + 0] = bflo(t.x); v[i * 8 + 1] = bfhi(t.x); v[i * 8 + 2] = bflo(t.y); v[i * 8 + 3] = bfhi(t.y); v[i * 8 + 4] = bflo(t.z); v[i * 8 + 5] = bfhi(t.z); v[i * 8 + 6] = bflo(t.w); v[i * 8 + 7] = bfhi(t.w); }
        }
        float ss = 0.f;
#pragma unroll
        for (int i = 0; i < 96; ++i) ss += v[i] * v[i];
        const float r = rsqrtf(ss * (1.f / 96.f) + EPS);
#pragma unroll
        for (int i = 0; i < 96; ++i) v[i] = v[i] * r * gain[i];
        const float* rt = (const float*)(p.ws + ROPET) + (size_t)s * 32;
#pragma unroll
        for (int i4 = 0; i4 < 4; ++i4) {
            const f32x4 cs = *(const f32x4*)(rt + i4 * 4), sn = *(const f32x4*)(rt + 16 + i4 * 4);
#pragma unroll
            for (int e = 0; e < 4; ++e) { const int i = i4 * 4 + e; const float x1 = v[64 + i], x2 = v[80 + i]; v[64 + i] = x1 * cs[e] - x2 * sn[e]; v[80 + i] = x1 * sn[e] + x2 * cs[e]; }
        }
        const float osc = isk ? 1.f : 0.14724444302f;
#pragma unroll
        for (int i = 0; i < 12; ++i) { u32x4 t; t.x = pack2(v[i * 8] * osc, v[i * 8 + 1] * osc); t.y = pack2(v[i * 8 + 2] * osc, v[i * 8 + 3] * osc); t.z = pack2(v[i * 8 + 4] * osc, v[i * 8 + 5] * osc); t.w = pack2(v[i * 8 + 6] * osc, v[i * 8 + 7] * osc);
            *(u32x4*)(vp + i * 8) = t; }
    }
}

DI void attn_phase(const Params& p, char* smem, int ctr_idx, bool qpost) {
    bf16_t* Ks = (bf16_t*)smem;
    bf16_t* Vs = Ks + 2 * 128 * 104;
    int* sh_u = (int*)(Vs + 2 * 64 * 136);
    const int tid = tid_fresh(), lane = tid & 63, w = tid >> 6, l31 = lane & 31, lh = lane >> 5;
    const int pi = (l31 & 0x13) | ((l31 & 4) << 1) | ((l31 & 8) >> 1);
    int koff_g[3], koff_l[3];
#pragma unroll
    for (int i = 0; i < 3; ++i) { const int c = tid + 512 * i; const int row = c / 12, part = c - row * 12; koff_g[i] = row * 16 * 96 + part * 8; koff_l[i] = row * 104 + part * 8; }
    const int voff_g0 = (tid >> 4) * S + (tid & 15) * 8, voff_l0 = (tid >> 4) * 136 + (tid & 15) * 8;
#define voff_g(i) (voff_g0 + (i) * 32 * S)
#define voff_l(i) (voff_l0 + (i) * 32 * 136)
    if (tid == 0) sh_u[1] = 0;
    for (int xi = 0; xi < 8; ++xi) {
    const int xq = ((int)(xb_xcc_id() & 7u) + xi) & 7;
    for (;;) {
        if (tid == 0) *sh_u = (int)atomicAdd((unsigned*)(p.ws + MISC) + ctr_idx * 512 + xq * 64, 1u);
        __syncthreads();
        const int u = *sh_u;
        __syncthreads();
        if (u >= 128) break;
        const int qt = 63 - (u >> 1), h = xq * 2 + (u & 1), q0 = qt * 256;
        const int nst = 2 * qt + 2, my_nkt = 4 * qt + 1 + (w >> 1);
        const bool sticky = __builtin_amdgcn_readfirstlane(sh_u[1]) != 0;
        for (int attempt = 0;; ++attempt) {
        const bool trk = sticky || attempt > 0;
        bf16x8 qf[6];
        {
            const bf16_t* qp = (const bf16_t*)(p.ws + QB) + ((size_t)(q0 + w * 32 + l31) * 16 + h) * 96 + lh * 8;
#pragma unroll
            for (int ks = 0; ks < 6; ++ks) qf[ks] = *(const bf16x8*)(qp + ks * 16);
        }
        if (qpost) {
            const int tok = q0 + w * 32 + l31;
            float v[6][8]; float ss = 0.f;
#pragma unroll
            for (int ks = 0; ks < 6; ++ks)
#pragma unroll
                for (int e = 0; e < 8; ++e) { v[ks][e] = bf2f((bf16_t)qf[ks][e]); ss += v[ks][e] * v[ks][e]; }
            ss += __shfl_xor(ss, 32);
            const float rs = rsqrtf(ss * (1.f / 96.f) + EPS);
#pragma unroll
            for (int ks = 0; ks < 6; ++ks) {
                const int d0 = ks * 16 + lh * 8; const f32x4 ga = *(const f32x4*)(p.b_q_norm + d0), gb = *(const f32x4*)(p.b_q_norm + d0 + 4);
#pragma unroll
                for (int e = 0; e < 4; ++e) { v[ks][e] *= rs * ga[e]; v[ks][e + 4] *= rs * gb[e]; }
                if (ks < 4) { const f32x4 ka = *(const f32x4*)(p.k_norm + d0), kb2 = *(const f32x4*)(p.k_norm + d0 + 4);
#pragma unroll
                    for (int e = 0; e < 4; ++e) { v[ks][e] *= ka[e]; v[ks][e + 4] *= kb2[e]; } }
            }
            {
                const float* rt = (const float*)(p.ws + ROPET) + (size_t)tok * 32 + lh * 8;
                const f32x4 c0 = *(const f32x4*)(rt), c1 = *(const f32x4*)(rt + 4), s0 = *(const f32x4*)(rt + 16), s1 = *(const f32x4*)(rt + 20);
#pragma unroll
                for (int e = 0; e < 4; ++e) {
                    { const float x1 = v[4][e], x2 = v[5][e]; v[4][e] = x1 * c0[e] - x2 * s0[e]; v[5][e] = x1 * s0[e] + x2 * c0[e]; }
                    { const float x1 = v[4][e + 4], x2 = v[5][e + 4]; v[4][e + 4] = x1 * c1[e] - x2 * s1[e]; v[5][e + 4] = x1 * s1[e] + x2 * c1[e]; }
                }
            }
            const float osc = 0.14724444302f;
#pragma unroll
            for (int ks = 0; ks < 6; ++ks) { u32x4 t; t.x = pack2(v[ks][0] * osc, v[ks][1] * osc); t.y = pack2(v[ks][2] * osc, v[ks][3] * osc); t.z = pack2(v[ks][4] * osc, v[ks][5] * osc); t.w = pack2(v[ks][6] * osc, v[ks][7] * osc);
                qf[ks] = __builtin_bit_cast(bf16x8, t); }
        }
        f32x16 O0, O1, negm;
#pragma unroll
        for (int i = 0; i < 16; ++i) { O0[i] = 0.f; O1[i] = 0.f; negm[i] = 0.f; }
        float lsum = 0.f;
        const bf16_t* Kh = (const bf16_t*)(p.ws + KB) + h * 96; const bf16_t* Vh = (const bf16_t*)(p.ws + VTM) + (size_t)h * 64 * S;
        u32x4 rk[3], rv[2];
#pragma unroll
        for (int i = 0; i < 3; ++i) rk[i] = *(const u32x4*)(Kh + koff_g[i]);
#pragma unroll
        for (int i = 0; i < 2; ++i) rv[i] = *(const u32x4*)(Vh + voff_g(i));
#pragma unroll
        for (int i = 0; i < 3; ++i) *(u32x4*)(Ks + koff_l[i]) = rk[i];
#pragma unroll
        for (int i = 0; i < 2; ++i) *(u32x4*)(Vs + voff_l(i)) = rv[i];
        __syncthreads();
        for (int st = 0; st < nst; ++st) {
            const int buf = st & 1; const bool more = st + 1 < nst;
            if (more) {
#pragma unroll
                for (int i = 0; i < 3; ++i) rk[i] = *(const u32x4*)(Kh + (size_t)(st + 1) * 128 * 16 * 96 + koff_g[i]);
#pragma unroll
                for (int i = 0; i < 2; ++i) rv[i] = *(const u32x4*)(Vh + (st + 1) * 128 + voff_g(i));
            }
#pragma unroll
            for (int sub = 0; sub < 2; ++sub) {
                const int tile = st * 2 + sub;
                if (tile < my_nkt) {
                    const bf16_t* kb = Ks + buf * 128 * 104 + (sub * 64 + pi) * 104 + lh * 8; const bf16_t* vb = Vs + buf * 64 * 136 + l31 * 136 + sub * 64 + lh * 8;
                    f32x16 s0, s1;
                    bf16x8 kf[12], vf[8];
#pragma unroll
                    for (int ks = 0; ks < 6; ++ks) { kf[2 * ks] = *(const bf16x8*)(kb + ks * 16); kf[2 * ks + 1] = *(const bf16x8*)(kb + 32 * 104 + ks * 16); }
                    __builtin_amdgcn_sched_barrier(0);
#pragma unroll
                    for (int ks = 0; ks < 4; ++ks) { vf[2 * ks] = *(const bf16x8*)(vb + ks * 16); vf[2 * ks + 1] = *(const bf16x8*)(vb + 32 * 136 + ks * 16); }
                    s0 = mfma32(kf[0], qf[0], negm); s1 = mfma32(kf[1], qf[0], negm);
#pragma unroll
                    for (int ks = 1; ks < 6; ++ks) { s0 = mfma32(kf[2 * ks], qf[ks], s0); s1 = mfma32(kf[2 * ks + 1], qf[ks], s1); }
                    __builtin_amdgcn_sched_barrier(0);
                    if (tile == 0 || trk) {
                    float mx = fmaxf(s0[0], s0[1]), mx1 = fmaxf(s1[0], s1[1]);
#pragma unroll
                    for (int i = 2; i < 16; i += 2) { mx = fmaxf(fmaxf(mx, s0[i]), s0[i + 1]); mx1 = fmaxf(fmaxf(mx1, s1[i]), s1[i + 1]); }
                    mx = fmaxf(mx, mx1);
                    { const auto sw = __builtin_amdgcn_permlane32_swap(__float_as_uint(mx), __float_as_uint(mx), false, false);
                      mx = fmaxf(__uint_as_float(sw[0]), __uint_as_float(sw[1])); }
                    if (tile == 0 || __any(mx > 8.f)) {
                        const float d = (tile == 0 || mx > 8.f) ? mx : 0.f;
                        const float alpha = __builtin_amdgcn_exp2f(-d);
                        lsum *= alpha;
#pragma unroll
                        for (int i = 0; i < 16; ++i) { O0[i] *= alpha; O1[i] *= alpha; s0[i] -= d; s1[i] -= d; negm[i] -= d; }
                    }
                    }
                    float r0 = 0.f, r1 = 0.f, r2 = 0.f, r3 = 0.f;
#pragma unroll
                    for (int i = 0; i < 16; i += 2) {
                        s0[i] = __builtin_amdgcn_exp2f(s0[i]); s0[i + 1] = __builtin_amdgcn_exp2f(s0[i + 1]); s1[i] = __builtin_amdgcn_exp2f(s1[i]); s1[i + 1] = __builtin_amdgcn_exp2f(s1[i + 1]);
                        r0 += s0[i]; asm("" : "+v"(r0)); r1 += s0[i + 1]; asm("" : "+v"(r1)); r2 += s1[i]; asm("" : "+v"(r2)); r3 += s1[i + 1]; asm("" : "+v"(r3));
                    }
                    lsum += (r0 + r1) + (r2 + r3);
                    bf16x8 pf[4];
                    {
                        u32x4 t;
                        t.x = pack2(s0[0], s0[1]); t.y = pack2(s0[2], s0[3]); t.z = pack2(s0[4], s0[5]); t.w = pack2(s0[6], s0[7]); pf[0] = __builtin_bit_cast(bf16x8, t);
                        t.x = pack2(s0[8], s0[9]); t.y = pack2(s0[10], s0[11]); t.z = pack2(s0[12], s0[13]); t.w = pack2(s0[14], s0[15]); pf[1] = __builtin_bit_cast(bf16x8, t);
                        t.x = pack2(s1[0], s1[1]); t.y = pack2(s1[2], s1[3]); t.z = pack2(s1[4], s1[5]); t.w = pack2(s1[6], s1[7]); pf[2] = __builtin_bit_cast(bf16x8, t);
                        t.x = pack2(s1[8], s1[9]); t.y = pack2(s1[10], s1[11]); t.z = pack2(s1[12], s1[13]); t.w = pack2(s1[14], s1[15]); pf[3] = __builtin_bit_cast(bf16x8, t);
                    }
#pragma unroll
                    for (int ks = 0; ks < 4; ++ks) { O0 = mfma32(vf[2 * ks], pf[ks], O0); O1 = mfma32(vf[2 * ks + 1], pf[ks], O1); }
                }
            }
            if (more) {
                bf16_t* kw = Ks + (buf ^ 1) * 128 * 104; bf16_t* vw = Vs + (buf ^ 1) * 64 * 136;
#pragma unroll
                for (int i = 0; i < 3; ++i) *(u32x4*)(kw + koff_l[i]) = rk[i];
#pragma unroll
                for (int i = 0; i < 2; ++i) *(u32x4*)(vw + voff_l(i)) = rv[i];
            }
            __syncthreads();
        }
        const float lt = lsum + __shfl_xor(lsum, 32);
        if (!trk) { const int bad = !(lt > 0.f && lt < 1e37f); if (__syncthreads_or(bad)) { if (tid == 0) sh_u[1] = 1; continue; } }
        const float inv = 1.f / lt;
        bf16_t* op = (bf16_t*)(p.ws + XH) + (size_t)(q0 + w * 32 + l31) * 1024 + h * 64 + lh * 4;
#pragma unroll
        for (int gq = 0; gq < 4; ++gq) {
            u32x2 a; a.x = pack2(O0[gq * 4] * inv, O0[gq * 4 + 1] * inv); a.y = pack2(O0[gq * 4 + 2] * inv, O0[gq * 4 + 3] * inv); *(u32x2*)(op + gq * 8) = a;
            u32x2 b; b.x = pack2(O1[gq * 4] * inv, O1[gq * 4 + 1] * inv); b.y = pack2(O1[gq * 4 + 2] * inv, O1[gq * 4 + 3] * inv); *(u32x2*)(op + 32 + gq * 8) = b;
        }
        break;
        }
    }
    }
}

DI void gl_phase(const Params& p, char* smem) {
    const int tid = tid_fresh(), lane = tid & 63, w = tid >> 6, mt = w & 3, kh = w >> 2, lr = lane & 15, lq = lane >> 4;
    float* part = (float*)smem;
    for (int ch = blockIdx.x; ch < 256; ch += gridDim.x) {
        const bf16_t* xa = (const bf16_t*)(p.ws + XH) + (size_t)(ch * 64 + mt * 16 + lr) * 1024 + kh * 512 + lq * 8;
        const bf16_t* wb = (const bf16_t*)(p.ws + W_GL) + (size_t)lr * 1024 + kh * 512 + lq * 8;
        bf16x8 xf[16], wf[16];
#pragma unroll
        for (int ks = 0; ks < 16; ++ks) { xf[ks] = *(const bf16x8*)(xa + ks * 32); wf[ks] = *(const bf16x8*)(wb + ks * 32); }
        f32x4 acc = (f32x4){0.f, 0.f, 0.f, 0.f};
#pragma unroll
        for (int ks = 0; ks < 16; ++ks) acc = mfma16(wf[ks], xf[ks], acc);
        if (kh == 1) *(f32x4*)(part + (mt * 64 + lane) * 4) = acc;
        __syncthreads();
        if (kh == 0) { const f32x4 o = acc + *(const f32x4*)(part + (mt * 64 + lane) * 4); *(f32x4*)((float*)(p.ws + GL) + ((size_t)ch * 64 + mt * 16 + lr) * 16 + lq * 4) = o; }
        __syncthreads();
    }
}

constexpr int NPH = 19;
DI void run_phase(const Params& p, int ph, char* smem) {
    const int dup = ph >= 100; if (dup) ph -= 100;
    const int G = gridDim.x, b = blockIdx.x;
    bf16_t* xh = (bf16_t*)(p.ws + XH);
    switch (ph) {
    case 0: {
        const int total = p.jstart[NJOBS]; const int tidp = tid_fresh();
        for (int t0 = b * 4; t0 < total; t0 += G * 4) {
#pragma unroll
            for (int q = 0; q < 4; ++q) { const int t = t0 + q; if (t < total) { int j = 0; while (t >= p.jstart[j + 1]) ++j; tr_load(p.jobs[j], t - p.jstart[j], (float*)smem + q * 64 * 65, tidp); } }
            __syncthreads();
#pragma unroll
            for (int q = 0; q < 4; ++q) { const int t = t0 + q; if (t < total) { int j = 0; while (t >= p.jstart[j + 1]) ++j; tr_store(p.jobs[j], t - p.jstart[j], (const float*)smem + q * 64 * 65, tidp); } }
            __syncthreads();
        }
        norm_phase(p.x, xh);
        { float* rt = (float*)(p.ws + ROPET);
          for (int idx = b * NT + tid_fresh(); idx < S * 16; idx += G * NT) { const int s = idx >> 4, i = idx & 15; const float ang = (float)p.pos[s] * p.inv_freq[i]; rt[s * 32 + i] = cosf(ang); rt[s * 32 + 16 + i] = sinf(ang); } }
    } break;
    case 1: { Epi<EPI_INPROJ> E{}; E.o0 = (bf16_t*)(p.ws + QK); E.o1 = (bf16_t*)(p.ws + VT); E.o2 = (bf16_t*)(p.ws + RB); E.outf = (float*)(p.ws + GL);
        gemm_phase<EPI_INPROJ>(xh, (const bf16_t*)(p.ws + W_IN), 3072, 1024, E, smem); gl_phase(p, smem); } break;
    case 2: { const int hf2 = tid_fresh() >> 8; for (int u0 = b * 2; u0 < 1024; u0 += 2 * G) gla_kv_unit(p, u0 + hf2, smem + hf2 * 53248); } break;
    case 3: gla_scan(p); break;
    case 4: { const int hf2 = tid_fresh() >> 8; for (int u0 = b * 2; u0 < 1024; u0 += 2 * G) gla_out_unit(p, u0 + hf2, smem + hf2 * 53248); } break;
    case 5: case 15: if (G == 256) { EpiResNorm E{}; E.res = ph == 5 ? p.x : p.out; E.outf = p.out; E.xh = xh; E.xbuf = (float*)(p.ws + XSLOT) + (ph == 5 ? 0 : 2 * 4 * S); E.cnt = (unsigned*)(p.ws + PCNT) + (ph == 5 ? 0 : 2 * 4096);
            gemm_phase_resnorm(xh, (const bf16_t*)(p.ws + (ph == 5 ? W_AOUT : W_BOUT)), 1024, E, smem); }
        else { Epi<EPI_RES> E{}; E.res = ph == 5 ? p.x : p.out; E.outf = p.out;
            gemm_phase<EPI_RES>(xh, (const bf16_t*)(p.ws + (ph == 5 ? W_AOUT : W_BOUT)), 1024, 1024, E, smem); } break;
    case 6: case 9: case 16: norm_phase(p.out, xh); break;
    case 7: case 17: { const int l = ph == 17; Epi<EPI_SWIGLU> E{}; E.o0 = (bf16_t*)(p.ws + HB);
        gemm_phase<EPI_SWIGLU>(xh, (const bf16_t*)(p.ws + W_FIN) + (size_t)l * 5632 * 1024, 5632, 1024, E, smem); } break;
    case 8: if (G == 256) { EpiResNorm E{}; E.res = p.out; E.outf = p.out; E.xh = xh; E.xbuf = (float*)(p.ws + XSLOT) + 4 * S; E.cnt = (unsigned*)(p.ws + PCNT) + 4096;
            gemm_phase_resnorm((const bf16_t*)(p.ws + HB), (const bf16_t*)(p.ws + W_FOUT), 2816, E, smem); break; }
    case 18: { const int l = ph == 18; Epi<EPI_RES> E{}; E.res = p.out; E.outf = p.out;
        gemm_phase<EPI_RES>((const bf16_t*)(p.ws + HB), (const bf16_t*)(p.ws + W_FOUT) + (size_t)l * 1024 * 2816, 1024, 2816, E, smem); } break;
    case 10: if (G == 256) { EpiLatent E{}; E.ckv = (bf16_t*)(p.ws + CKV); E.cq = (bf16_t*)(p.ws + CQ); E.krope = (float*)(p.ws + KROPE); E.xbuf = (float*)(p.ws + XSLOT) + 3 * 4 * S; E.cnt = (unsigned*)(p.ws + PCNT) + 3 * 4096; E.ropet = (const float*)(p.ws + ROPET); E.kgain = p.k_norm; E.krss = (float*)(p.ws + KRSS);
            gemm_phase_latent(xh, (const bf16_t*)(p.ws + W_DD), E, smem); }
        else { Epi<EPI_F32> E{}; E.outf = (float*)(p.ws + DBUF); E.ldo = 768;
            gemm_phase<EPI_F32>(xh, (const bf16_t*)(p.ws + W_DD), 768, 1024, E, smem); } break;
    case 11: latent_norm_phase(p); break;
    case 12: {
        if (G == 256) { EpiKV2 E{}; E.kb = (bf16_t*)(p.ws + KB); E.vt = (bf16_t*)(p.ws + VTM); E.krss = (const float*)(p.ws + KRSS); E.krope = (const float*)(p.ws + KROPE);
          gemm_phase_kv2((const bf16_t*)(p.ws + CKV), (const bf16_t*)(p.ws + W_UP), E, smem); }
        else { Epi<EPI_KV> E{}; E.o0 = (bf16_t*)(p.ws + KB); E.o1 = (bf16_t*)(p.ws + VTM);
          gemm_phase<EPI_KV>((const bf16_t*)(p.ws + CKV), (const bf16_t*)(p.ws + W_UP), 2048, 256, E, smem); }
        { Epi<EPI_BF16> E{}; E.o0 = (bf16_t*)(p.ws + QB); E.ldo = 1536;
          gemm_phase<EPI_BF16>((const bf16_t*)(p.ws + CQ), (const bf16_t*)(p.ws + W_UQ), 1536, 384, E, smem); }
    } break;
    case 13: qk_post_phase(p); break;
    case 14: attn_phase(p, smem, dup, G == 256); break;
    default: break;
    }
}

__global__ void __launch_bounds__(NT, 2) yoco_mega(const Params p) {
    extern __shared__ __attribute__((aligned(16))) char smem[];
#if MULTI_LAUNCH
    run_phase(p, p.ph_lo, smem);
#else
    cg::grid_group grid = cg::this_grid();
    __shared__ uint4 xb_words;
    if (threadIdx.x == 0) xb_words = make_uint4(0u, 0u, 0u, 0u);
    __syncthreads();
    XcdBarrier xb = xcd_barrier_post((unsigned*)(p.ws + MISC_BAR), (volatile LAS unsigned*)&xb_words);
    if (p.ph_hi == 0x7fffffff) grid.sync();
    run_phase(p, 0, smem); xcd_barrier(xb);
#ifdef DUP0
    run_phase(p, 0, smem); xcd_barrier(xb);
#endif
#ifndef DUP
#define DUP 0
#endif
#define PHASE(n) run_phase(p, n, smem); xcd_barrier(xb); if ((DUP >> n) & 1) { run_phase(p, n + 100, smem); xcd_barrier(xb); }
    PHASE(1) PHASE(2) PHASE(3) PHASE(4)
#ifdef DUPGLA
    PHASE(2) PHASE(3) PHASE(4)
#endif
    const bool fuse = gridDim.x == 256;
    PHASE(5) if (!fuse) { PHASE(6) } PHASE(7) PHASE(8) if (!fuse) { PHASE(9) }
    PHASE(10) if (!fuse) { PHASE(11) } PHASE(12) if (!fuse) { PHASE(13) } PHASE(14) PHASE(15) if (!fuse) { PHASE(16) } PHASE(17)
    run_phase(p, 18, smem);
#undef PHASE
#endif
}

extern "C" void kernel_launch(void* const* d_in, const int* in_sizes, int n_in, void* d_out, int out_size, void* d_ws, size_t ws_size, hipStream_t stream) {
    static int grid_blocks = 0;
    if (grid_blocks == 0) {
        if (n_in != 22 || ws_size < WS_NEED) { fprintf(stderr, "kernel_launch: unexpected n_in %d / ws %zu (need %zu)\n", n_in, ws_size, (size_t)WS_NEED); grid_blocks = -1; return; }
        int dev = 0, cus = 0, per_cu = 0;
        hipGetDevice(&dev); hipDeviceGetAttribute(&cus, hipDeviceAttributeMultiprocessorCount, dev);
        if (hipFuncSetAttribute((const void*)yoco_mega, hipFuncAttributeMaxDynamicSharedMemorySize, LDS_BYTES) != hipSuccess) { fprintf(stderr, "kernel_launch: hipFuncSetAttribute failed\n"); grid_blocks = -1; return; }
        if (hipOccupancyMaxActiveBlocksPerMultiprocessor(&per_cu, (const void*)yoco_mega, NT, LDS_BYTES) != hipSuccess || per_cu < 1) { fprintf(stderr, "kernel_launch: occupancy query failed (%d)\n", per_cu); grid_blocks = -1; return; }
        if (per_cu > 1) per_cu = 1;
        grid_blocks = cus * per_cu;
        fprintf(stderr, "kernel_launch: cus %d per_cu %d grid %d\n", cus, per_cu, grid_blocks);
    }
    if (grid_blocks < 0) return;
    Params p; memset(&p, 0, sizeof(p));
    p.x = (const float*)d_in[0]; p.pos = (const int*)d_in[1];
    p.a_norm = (const float*)d_in[2]; p.a_w_in = (const float*)d_in[3]; p.a_w_gate_up = (const float*)d_in[4]; p.a_b_gate = (const float*)d_in[5]; p.a_out_norm = (const float*)d_in[6]; p.a_w_out = (const float*)d_in[7];
    p.b_norm = (const float*)d_in[8]; p.b_w_dq = (const float*)d_in[9]; p.b_q_latent_norm = (const float*)d_in[10]; p.b_w_uq = (const float*)d_in[11]; p.b_q_norm = (const float*)d_in[12]; p.b_w_out = (const float*)d_in[13];
    p.kv_norm = (const float*)d_in[14]; p.kv_w_down = (const float*)d_in[15]; p.kv_latent_norm = (const float*)d_in[16]; p.kv_w_up = (const float*)d_in[17]; p.k_norm = (const float*)d_in[18];
    p.f_norm = (const float*)d_in[19]; p.f_w_in = (const float*)d_in[20]; p.f_w_out = (const float*)d_in[21];
    p.out = (float*)d_out; p.ws = (char*)d_ws;
    char* ws = (char*)d_ws;
    auto job = [&](int i, const float* src, const float* gain, size_t dst, int ldn, int col0, int nvalid, int nrows, int K, int mode) {
        p.jobs[i].src = src; p.jobs[i].gain = gain; p.jobs[i].dst = (bf16_t*)(ws + dst); p.jobs[i].ldn = ldn; p.jobs[i].col0 = col0; p.jobs[i].nvalid = nvalid; p.jobs[i].nrows = nrows; p.jobs[i].K = K; p.jobs[i].mode = mode; };
    job(0, p.a_w_in, p.a_norm, W_IN, 3088, 0, 3072, 3072, 1024, 0);
    job(12, p.a_w_in, p.a_norm, W_GL, 3088, 3072, 16, 64, 1024, 0);
    job(1, p.a_w_out, nullptr, W_AOUT, 1024, 0, 1024, 1024, 1024, 0);
    job(2, p.f_w_in, p.f_norm, W_FIN, 5632, 0, 5632, 5632, 1024, 1);
    job(3, p.f_w_in + (size_t)1024 * 5632, p.f_norm + 1024, W_FIN + (size_t)5632 * 1024 * 2, 5632, 0, 5632, 5632, 1024, 1);
    job(4, p.f_w_out, nullptr, W_FOUT, 1024, 0, 1024, 1024, 2816, 0);
    job(5, p.f_w_out + (size_t)2816 * 1024, nullptr, W_FOUT + (size_t)1024 * 2816 * 2, 1024, 0, 1024, 1024, 2816, 0);
    job(6, p.kv_w_down, p.kv_norm, W_DD, 288, 0, 256, 256, 1024, 0);
    job(7, p.b_w_dq, p.b_norm, W_DD + (size_t)256 * 1024 * 2, 384, 0, 384, 384, 1024, 0);
    job(8, p.kv_w_down, p.kv_norm, W_DD + (size_t)640 * 1024 * 2, 288, 256, 32, 128, 1024, 0);
    job(9, p.kv_w_up, p.kv_latent_norm, W_UP, 2048, 0, 2048, 2048, 256, grid_blocks == 256 ? 2 : 0);
    job(10, p.b_w_uq, p.b_q_latent_norm, W_UQ, 1536, 0, 1536, 1536, 384, 0);
    job(11, p.b_w_out, nullptr, W_BOUT, 1024, 0, 1024, 1024, 1024, 0);
    p.jstart[0] = 0;
    for (int i = 0; i < NJOBS; ++i) p.jstart[i + 1] = p.jstart[i] + (p.jobs[i].nrows / 64) * (p.jobs[i].K / 64);
    for (int i = 0; i < 16; ++i) p.inv_freq[i] = (float)pow(10000.0, -(double)i / 16.0);
    if (hipMemsetAsync(ws + MISC, 0, MISC_ZERO_BYTES, stream) != hipSuccess) fprintf(stderr, "kernel_launch: memset failed\n");
#if MULTI_LAUNCH
    for (int ph = 0; ph < NPH; ++ph) { p.ph_lo = ph; p.ph_hi = ph + 1; hipLaunchKernelGGL(yoco_mega, dim3(grid_blocks), dim3(NT), LDS_BYTES, stream, p); }
#else
    void* args[] = {(void*)&p};
    hipError_t e = hipLaunchCooperativeKernel((const void*)yoco_mega, dim3(grid_blocks), dim3(NT), args, LDS_BYTES, stream);
    if (e != hipSuccess) fprintf(stderr, "kernel_launch: cooperative launch failed: %s (grid %d)\n", hipGetErrorString(e), grid_blocks);
#endif
}
```

```cpp
#include <hip/hip_runtime.h>
#include <hip/hip_cooperative_groups.h>
#include <stdint.h>
#include <stdio.h>
#include <string.h>
#include <math.h>
namespace cg = cooperative_groups;

#ifndef MULTI_LAUNCH
#define MULTI_LAUNCH 0
#endif

typedef unsigned short bf16_t;
typedef short bf16x8 __attribute__((ext_vector_type(8)));
typedef float f32x2 __attribute__((ext_vector_type(2)));
typedef float f32x4 __attribute__((ext_vector_type(4)));
typedef float f32x16 __attribute__((ext_vector_type(16)));
typedef unsigned u32x2 __attribute__((ext_vector_type(2)));
typedef unsigned u32x4 __attribute__((ext_vector_type(4)));
typedef __bf16 bf16v2 __attribute__((ext_vector_type(2)));

#define DI __device__ __forceinline__
DI unsigned pack2(float a, float b) { f32x2 v = {a, b}; return __builtin_bit_cast(unsigned, __builtin_convertvector(v, bf16v2)); }
DI bf16_t f2bf(float a) { return (bf16_t)(pack2(a, 0.f) & 0xffffu); }
DI float bf2f(bf16_t v) { return __uint_as_float(((unsigned)v) << 16); }
DI float bflo(unsigned u) { return __uint_as_float(u << 16); }
DI float bfhi(unsigned u) { return __uint_as_float(u & 0xffff0000u); }
DI f32x4 mfma16(bf16x8 a, bf16x8 b, f32x4 c) { return __builtin_amdgcn_mfma_f32_16x16x32_bf16(a, b, c, 0, 0, 0); }
DI f32x16 mfma32(bf16x8 a, bf16x8 b, f32x16 c) { return __builtin_amdgcn_mfma_f32_32x32x16_bf16(a, b, c, 0, 0, 0); }
DI float nopack(float x) { asm("" : "+v"(x)); return x; }
DI float siluf(float x) { return x * __builtin_amdgcn_rcpf(1.f + __expf(-x)); }
DI int tid_fresh() { int t = threadIdx.x; asm volatile("" : "+v"(t)); return t; }


#define XB_TMO      128
#define XB_XCNT(j)  (256  + 64 * (j))
#define XB_XSUB(j)  (1280 + 64 * (j))
#define XB_XGEN(j)  (2304 + 64 * (j))
#define XB_TOP      3328
#define XB_TOPGEN   3392
#define XCD_BAR_WORDS 3456
#define XB_SPIN_CAP (1u << 22)
#define LAS __attribute__((address_space(3)))
DI unsigned xb_ld(unsigned* p)              { return __hip_atomic_load(p, __ATOMIC_RELAXED, __HIP_MEMORY_SCOPE_AGENT); }
DI unsigned xb_add(unsigned* p, unsigned v) { return __hip_atomic_fetch_add(p, v, __ATOMIC_RELAXED, __HIP_MEMORY_SCOPE_AGENT); }
DI unsigned xb_xcc_id() { return (unsigned)__builtin_amdgcn_s_getreg((3 << 11) | 20) & 0xFu; }
#define XB_SPIN(cond, bar) do { unsigned _sp = 0; while (cond) { __builtin_amdgcn_s_sleep(1); \
    if ((++_sp & 255u) == 0u) { if (xb_ld(&(bar)[XB_TMO])) break; if (_sp > XB_SPIN_CAP) { atomicAdd(&(bar)[XB_TMO], 1u); break; } } } } while (0)
struct XcdBarrier { unsigned* bar; unsigned x; volatile LAS unsigned* st; };
DI XcdBarrier xcd_barrier_post(unsigned* bar, volatile LAS unsigned* st) {
    XcdBarrier b; b.bar = bar; b.x = xb_xcc_id(); b.st = st;
    if (threadIdx.x == 0) (void)xb_add(&bar[XB_XCNT(b.x)], 1u);
    return b;
}
DI void xcd_barrier_complete(unsigned* bar, unsigned x, unsigned& nloc, unsigned& nx) {
    const unsigned G = gridDim.x * gridDim.y * gridDim.z;
    unsigned sum, cnt, mine, sp = 0u;
    for (;;) {
        sum = 0u; cnt = 0u; mine = 0u;
#pragma unroll
        for (unsigned j = 0; j < 16; ++j) { const unsigned c = xb_ld(&bar[XB_XCNT(j)]); sum += c; cnt += (c > 0u) ? 1u : 0u; mine = (j == x) ? c : mine; }
        if (sum == G) break;
        __builtin_amdgcn_s_sleep(1);
        if ((++sp & 255u) == 0u) { if (xb_ld(&bar[XB_TMO])) break; if (sp > XB_SPIN_CAP) { atomicAdd(&bar[XB_TMO], 1u); break; } }
    }
    nloc = mine > 0u ? mine : 1u; nx = cnt > 0u ? cnt : 1u;
}
DI void xcd_barrier(const XcdBarrier& b) {
    asm volatile("s_waitcnt vmcnt(0)" ::: "memory");
    __syncthreads();
    if (threadIdx.x == 0) {
        unsigned* bar = b.bar;
        __builtin_amdgcn_s_waitcnt(0);
        unsigned nloc = b.st[0], nx = b.st[1];
        if (nloc == 0u) { xcd_barrier_complete(bar, b.x, nloc, nx); b.st[0] = nloc; b.st[1] = nx; }
        const unsigned old = xb_add(&bar[XB_XSUB(b.x)], 1u);
        const unsigned gen = old / nloc;
        if (old + 1u == (gen + 1u) * nloc) {
            __builtin_amdgcn_fence(__ATOMIC_RELEASE, "agent");
            asm volatile("s_waitcnt vmcnt(0)" ::: "memory");
            const unsigned og = xb_add(&bar[XB_TOP], 1u);
            const unsigned tg = og / nx;
            if (og + 1u == (tg + 1u) * nx) xb_add(&bar[XB_TOPGEN], 1u);
            else XB_SPIN(xb_ld(&bar[XB_TOPGEN]) == tg, bar);
            __builtin_amdgcn_fence(__ATOMIC_ACQUIRE, "agent");
            xb_add(&bar[XB_XGEN(b.x)], 1u);
            asm volatile("s_waitcnt vmcnt(0)" ::: "memory");
        } else {
            XB_SPIN(xb_ld(&bar[XB_XGEN(b.x)]) == gen, bar);
            __builtin_amdgcn_fence(__ATOMIC_ACQUIRE, "agent");
            asm volatile("s_waitcnt vmcnt(0)" ::: "memory");
        }
    }
    __syncthreads();
}

constexpr int S = 16384;
constexpr int NT = 512;
constexpr float EPS = 1e-6f;
constexpr size_t MiB = 1u << 20;
constexpr size_t W_IN = 0;
constexpr size_t W_GL = W_IN + (size_t)3072 * 1024 * 2;
constexpr size_t W_AOUT = W_IN + (size_t)3328 * 1024 * 2;
constexpr size_t W_FIN = W_AOUT + (size_t)1024 * 1024 * 2;
constexpr size_t W_FOUT = W_FIN + (size_t)2 * 5632 * 1024 * 2;
constexpr size_t W_DD = W_FOUT + (size_t)2 * 1024 * 2816 * 2;
constexpr size_t W_UP = W_DD + (size_t)768 * 1024 * 2;
constexpr size_t W_UQ = W_UP + (size_t)2048 * 256 * 2;
constexpr size_t W_BOUT = W_UQ + (size_t)1536 * 384 * 2;
constexpr size_t W_END = W_BOUT + (size_t)1024 * 1024 * 2;
static_assert(W_END <= 47 * MiB + 512 * 1024, "weights");
constexpr size_t MISC = 47 * MiB + 512 * 1024;
constexpr size_t MISC_BAR = MISC + 4096;
constexpr size_t PCNT = MISC + 32768;
constexpr size_t MISC_ZERO_BYTES = 32768 + 4 * 16384;
constexpr size_t XH = 48 * MiB;
constexpr size_t R = 80 * MiB;
constexpr size_t QK = R;
constexpr size_t VT = R + 32 * MiB;
constexpr size_t RB = R + 64 * MiB;
constexpr size_t GL = R + 96 * MiB;
constexpr size_t DEC = R + 97 * MiB;
constexpr size_t KVT = R + 98 * MiB;
constexpr size_t HB = R;
constexpr size_t CKV = R;
constexpr size_t CQ = R + 8 * MiB;
constexpr size_t KROPE = R + 20 * MiB;
constexpr size_t DBUF = R + 22 * MiB;
constexpr size_t QB = R + 22 * MiB;
constexpr size_t KB = R + 70 * MiB;
constexpr size_t VTM = R + 118 * MiB;
constexpr size_t ROPET = R + 162 * MiB;
constexpr size_t XSLOT = R + 164 * MiB;
constexpr size_t KRSS = XSLOT + 917504;
constexpr size_t WS_NEED = R + 165 * MiB;
static_assert(WS_NEED <= 256 * MiB, "ws");

constexpr int LDS_BYTES = 131072;

struct TJob { const float* src; const float* gain; bf16_t* dst; int ldn, col0, nvalid, nrows, K, mode; };
constexpr int NJOBS = 13;

struct Params {
    const float* x; const int* pos;
    const float *a_norm, *a_w_in, *a_w_gate_up, *a_b_gate, *a_out_norm, *a_w_out;
    const float *b_norm, *b_w_dq, *b_q_latent_norm, *b_w_uq, *b_q_norm, *b_w_out;
    const float *kv_norm, *kv_w_down, *kv_latent_norm, *kv_w_up, *k_norm;
    const float *f_norm, *f_w_in, *f_w_out;
    float* out; char* ws;
    TJob jobs[NJOBS];
    int jstart[NJOBS + 1];
    int ph_lo, ph_hi, pad0;
    float inv_freq[16];
};

DI void tr_load(const TJob& j, int t, float* tile, int tid) {
    const int ktn = j.K >> 6; const int rt = t / ktn, kt = t - rt * ktn; const int r0 = rt * 64, k0 = kt * 64;
    const int rl = tid & 63, kq = tid >> 6; const int r = r0 + rl; int sc; bool valid;
    if (j.mode == 0) { valid = r < j.nvalid; sc = j.col0 + r; }
    else if (j.mode == 2) { const int cl = r & 255, wcc = (cl >> 5) & 3; sc = ((r >> 8) * 2 + (wcc >> 1)) * 128 + (wcc & 1) * 64 + (cl >> 7) * 32 + (cl & 31); valid = true; }
    else { sc = ((r >> 7) & 1) * 2816 + (r >> 8) * 128 + (r & 127); valid = true; }
    float v[8];
#pragma unroll
    for (int kk = 0; kk < 8; ++kk) { const int k = k0 + kq * 8 + kk; v[kk] = 0.f; if (valid) { v[kk] = __builtin_nontemporal_load(j.src + (size_t)k * j.ldn + sc); if (j.gain) v[kk] *= j.gain[k];     } }
#pragma unroll
    for (int kk = 0; kk < 8; ++kk) tile[(kq * 8 + kk) * 65 + rl] = v[kk];
}
DI void tr_store(const TJob& j, int t, const float* tile, int tid) {
    const int ktn = j.K >> 6; const int rt = t / ktn, kt = t - rt * ktn; const int r0 = rt * 64, k0 = kt * 64;
    const int kl2 = tid & 31, rq = tid >> 5;
#pragma unroll
    for (int rr = 0; rr < 4; ++rr) { const int r = rq * 4 + rr; *(unsigned*)(j.dst + (size_t)(r0 + r) * j.K + k0 + 2 * kl2) = pack2(tile[(2 * kl2) * 65 + r], tile[(2 * kl2 + 1) * 65 + r]); }
}

DI void norm_phase(const float* x, bf16_t* out) {
    const int tidf = tid_fresh(); const int lane = tidf & 63; const int gw = (blockIdx.x * NT + tidf) >> 6, nw = (gridDim.x * NT) >> 6;
    for (int row = gw; row < S; row += nw) {
        const float* xp = x + (size_t)row * 1024 + lane * 4;
        f32x4 v[4]; float ss = 0.f;
#pragma unroll
        for (int i = 0; i < 4; ++i) { v[i] = *(const f32x4*)(xp + i * 256); ss += v[i][0] * v[i][0] + v[i][1] * v[i][1] + v[i][2] * v[i][2] + v[i][3] * v[i][3]; }
#pragma unroll
        for (int o = 32; o >= 1; o >>= 1) ss += __shfl_xor(ss, o);
        const float r = rsqrtf(ss * (1.f / 1024.f) + EPS);
        bf16_t* op = out + (size_t)row * 1024 + lane * 4;
#pragma unroll
        for (int i = 0; i < 4; ++i) { u32x2 w; w.x = pack2(v[i][0] * r, v[i][1] * r); w.y = pack2(v[i][2] * r, v[i][3] * r); *(u32x2*)(op + i * 256) = w; }
    }
}

namespace pg8 {
#define PG8_LAS __attribute__((address_space(3)))
constexpr int BM = 256, BK = 64, HALF = 128, HTB = HALF * BK * 2  , STAGE_BYTES = 8 * HTB, NXCD = 8, WGM = 8;

__host__ __device__ __forceinline__ int lds_byte(int r, int c) { const int st = (r >> 4) * 2 + (c >> 5), rr = r & 15, cc = c & 31, ob = rr * 64 + cc * 2; return st * 1024 + (ob ^ (((ob >> 9) & 1) << 5)); }
__host__ __device__ __forceinline__ void stage_rc(int b, int& R, int& C) { const int st = b / 1024, sb = b % 1024, swz = sb ^ (((sb >> 9) & 1) << 5); R = (st >> 1) * 16 + swz / 64; C = (st & 1) * 32 + (swz % 64) / 2; }
__host__ __device__ __forceinline__ int perm32(int rho) { const int n = rho >> 4, i = rho & 15; return 8 * (i >> 2) + 4 * n + (i & 3); }

struct Unit { int pm, pn; };
struct Gemm { const bf16_t* A; const bf16_t* Bt; int M, N, K; };

struct StaticOrder {
    int nM, nN, nwg, G, c;
    __host__ __device__ void init(int M, int N, int G_, int c_) { nM = M / BM; nN = N / BM; nwg = nM * nN; G = G_; c = c_; }
    __host__ __device__ bool next(int i, Unit& u) const {
        const long L = (long)i * G + c; if (L >= nwg) return false;
        int wgid = (int)L; { const int q = nwg / NXCD, r = nwg % NXCD, xcd = wgid % NXCD, off = wgid / NXCD; wgid = (xcd < r ? xcd * (q + 1) : r * (q + 1) + (xcd - r) * q) + off; }
        const int nig = WGM * nN, gid = wgid / nig, fm = gid * WGM, gsz = (nM - fm) < WGM ? (nM - fm) : WGM;
        u.pm = fm + ((wgid % nig) % gsz); u.pn = (wgid % nig) / gsz; return true;
    }
    __device__ __forceinline__ void a_ready(const Unit&) const {}
    __device__ __forceinline__ void done(const Unit&) const {}
};


template <class Epi, class Sched, bool ALIGN_EPI = false, bool SP2 = false>
__device__ __forceinline__ void gemm_phase(PG8_LAS unsigned char* lds, const Gemm g, const Sched& S, const Epi& E) {
    const int tid = tid_fresh(), wid = __builtin_amdgcn_readfirstlane(tid >> 6), lane = tid & 63, wr = wid >> 2, wc = wid & 3, fr = lane & 15, fq = lane >> 4;
    const int K = g.K, nt = K / BK;
    unsigned voffA[2], voffB[2];
#pragma unroll
    for (int i = 0; i < 2; ++i) { int R, C; stage_rc(tid * 16 + i * 8192, R, C); const int Rb = Epi::PERM ? ((R & ~31) + perm32(R & 31)) : R;
        voffA[i] = (unsigned)(R * K + C) * 2u; voffB[i] = (unsigned)(Rb * K + C) * 2u; }
    const size_t kstep = (size_t)(BK * 2);
    const size_t hstep = (size_t)HALF * K * 2;
    const size_t tstep = 2 * hstep;
    const unsigned ldsw = (unsigned)wid * 1024u;
    const int aoff = lds_byte(wr * 64 + fr, fq * 8), boff = lds_byte(wc * 32 + fr, fq * 8);
#define PG8_SA(b, h) (((b) * 2 + (h)) * HTB)
#define PG8_SB(b, h) ((4 + (b) * 2 + (h)) * HTB)
#define PG8_STAGE(bufoff, gbase, voff) do { _Pragma("unroll") for (int _i = 0; _i < 2; ++_i) \
        __builtin_amdgcn_global_load_lds((const unsigned*)((const char*)(gbase) + (voff)[_i]), (PG8_LAS unsigned*)(lds + (bufoff) + ldsw + _i * 8192), 16, 0, 0); } while (0)
#define PG8_LDA(dst, b, h) do { _Pragma("unroll") for (int m = 0; m < 4; ++m) _Pragma("unroll") for (int k = 0; k < 2; ++k) dst[m][k] = *(const PG8_LAS bf16x8*)(lds + PG8_SA(b, h) + aoff + m * 2048 + k * 1024); } while (0)
#define PG8_LDB(dst, b, h) do { _Pragma("unroll") for (int n = 0; n < 2; ++n) _Pragma("unroll") for (int k = 0; k < 2; ++k) dst[n][k] = *(const PG8_LAS bf16x8*)(lds + PG8_SB(b, h) + boff + n * 2048 + k * 1024); } while (0)
#define PG8_MMA(ai, bj, At, Bt) do { __builtin_amdgcn_s_setprio(1); _Pragma("unroll") for (int m = 0; m < 4; ++m) _Pragma("unroll") for (int n = 0; n < 2; ++n) _Pragma("unroll") for (int k = 0; k < 2; ++k) \
        acc[ai][bj][m][n] = __builtin_amdgcn_mfma_f32_16x16x32_bf16(Bt[n][k], At[m][k], acc[ai][bj][m][n], 0, 0, 0); __builtin_amdgcn_s_setprio(0); } while (0)
#define PG8_WAIT_V(n) asm volatile("s_waitcnt vmcnt(" #n ")" ::: "memory")
#define PG8_WAIT_L(n) asm volatile("s_waitcnt lgkmcnt(" #n ")" ::: "memory")
#define PG8_BAR __builtin_amdgcn_s_barrier()
#define PG8_SCHED __builtin_amdgcn_sched_barrier(0)
    Unit cur, nxt; int ui = 0;
    if (!S.next(0, cur)) return;
    f32x4 acc[2][2][4][2];
#pragma unroll
    for (int a = 0; a < 2; ++a)
#pragma unroll
        for (int b = 0; b < 2; ++b)
#pragma unroll
            for (int m = 0; m < 4; ++m)
#pragma unroll
                for (int n = 0; n < 2; ++n) acc[a][b][m][n] = (f32x4){0.f, 0.f, 0.f, 0.f};
    bf16x8 At[4][2], B0[2][2], B1[2][2];
    const char* cA = (const char*)g.A + (size_t)cur.pm * tstep; const char* cB = (const char*)g.Bt + (size_t)cur.pn * tstep;
    S.a_ready(cur);
    if constexpr (SP2) {
        PG8_STAGE(PG8_SB(0, 0), cB, voffB); PG8_STAGE(PG8_SB(0, 1), cB + hstep, voffB); PG8_STAGE(PG8_SA(0, 0), cA, voffA); PG8_STAGE(PG8_SA(0, 1), cA + hstep, voffA);
        if (wr == 1) PG8_BAR;
        PG8_WAIT_V(2); PG8_BAR;
        PG8_STAGE(PG8_SB(1, 0), cB + kstep, voffB); PG8_STAGE(PG8_SA(1, 0), cA + kstep, voffA); PG8_STAGE(PG8_SB(1, 1), cB + hstep + kstep, voffB);
        PG8_WAIT_V(6); PG8_BAR;
    } else {
        PG8_STAGE(PG8_SB(0, 0), cB, voffB); PG8_STAGE(PG8_SA(0, 0), cA, voffA); PG8_STAGE(PG8_SB(0, 1), cB + hstep, voffB); PG8_STAGE(PG8_SA(0, 1), cA + hstep, voffA);
        if (wr == 1) PG8_BAR;
        PG8_WAIT_V(4); PG8_BAR;
        PG8_STAGE(PG8_SB(1, 0), cB + kstep, voffB); PG8_STAGE(PG8_SA(1, 0), cA + kstep, voffA); PG8_STAGE(PG8_SB(1, 1), cB + hstep + kstep, voffB);
        PG8_WAIT_V(6); PG8_BAR;
    }
    for (;;) {
        const bool has_next = S.next(ui + 1, nxt);
        const char* nA = has_next ? (const char*)g.A + (size_t)nxt.pm * tstep : cA; const char* nB = has_next ? (const char*)g.Bt + (size_t)nxt.pn * tstep : cB;
        for (int t = 0; t < nt; t += 2) {
            const bool last = (t == nt - 2);
            const char* a1 = cA + (size_t)(t + 1) * kstep;
            const char* a2 = last ? nA : cA + (size_t)(t + 2) * kstep; const char* b2 = last ? nB : cB + (size_t)(t + 2) * kstep;
            const char* a3 = a2 + kstep; const char* b3 = b2 + kstep;
            if (last && has_next) S.a_ready(nxt);
            if constexpr (SP2) {
            PG8_LDB(B0, 0, 0); PG8_LDB(B1, 0, 1); PG8_SCHED; PG8_LDA(At, 0, 0); PG8_STAGE(PG8_SA(1, 1), a1 + hstep, voffA);
            PG8_WAIT_V(8); PG8_WAIT_L(0); PG8_BAR; PG8_MMA(0, 0, At, B0); PG8_MMA(0, 1, At, B1); PG8_BAR; PG8_SCHED;
            PG8_LDA(At, 0, 1); PG8_STAGE(PG8_SB(0, 0), b2, voffB); PG8_STAGE(PG8_SB(0, 1), b2 + hstep, voffB); PG8_STAGE(PG8_SA(0, 0), a2, voffA);
            PG8_WAIT_V(8); PG8_WAIT_L(0); PG8_BAR; PG8_MMA(1, 0, At, B0); PG8_MMA(1, 1, At, B1); PG8_BAR; PG8_SCHED;
            PG8_LDB(B0, 1, 0); PG8_LDB(B1, 1, 1); PG8_SCHED; PG8_LDA(At, 1, 0); PG8_STAGE(PG8_SA(0, 1), a2 + hstep, voffA);
            PG8_WAIT_V(8); PG8_WAIT_L(0); PG8_BAR; PG8_MMA(0, 0, At, B0); PG8_MMA(0, 1, At, B1); PG8_BAR; PG8_SCHED;
            PG8_LDA(At, 1, 1); PG8_STAGE(PG8_SB(1, 0), b3, voffB); PG8_STAGE(PG8_SB(1, 1), b3 + hstep, voffB); PG8_STAGE(PG8_SA(1, 0), a3, voffA);
            PG8_WAIT_V(8); PG8_WAIT_L(0); PG8_BAR; PG8_MMA(1, 0, At, B0); PG8_MMA(1, 1, At, B1); PG8_BAR; PG8_SCHED;
            } else {
            PG8_LDB(B0, 0, 0); PG8_SCHED; PG8_LDA(At, 0, 0); PG8_STAGE(PG8_SA(1, 1), a1 + hstep, voffA);
            PG8_WAIT_L(8); PG8_BAR; PG8_WAIT_L(0); PG8_MMA(0, 0, At, B0); PG8_BAR; PG8_SCHED;
            PG8_LDB(B1, 0, 1); PG8_STAGE(PG8_SB(0, 0), b2, voffB);
            PG8_BAR; PG8_WAIT_L(0); PG8_MMA(0, 1, At, B1); PG8_BAR;
            PG8_LDA(At, 0, 1); PG8_STAGE(PG8_SA(0, 0), a2, voffA);
            PG8_BAR; PG8_WAIT_L(0); PG8_MMA(1, 0, At, B0); PG8_BAR; PG8_SCHED;
            PG8_STAGE(PG8_SB(0, 1), b2 + hstep, voffB);
            PG8_WAIT_V(6); PG8_BAR; PG8_MMA(1, 1, At, B1); PG8_BAR;
            PG8_LDB(B0, 1, 0); PG8_SCHED; PG8_LDA(At, 1, 0); PG8_STAGE(PG8_SA(0, 1), a2 + hstep, voffA);
            PG8_WAIT_L(8); PG8_BAR; PG8_WAIT_L(0); PG8_MMA(0, 0, At, B0); PG8_BAR; PG8_SCHED;
            PG8_LDB(B1, 1, 1); PG8_STAGE(PG8_SB(1, 0), b3, voffB);
            PG8_BAR; PG8_WAIT_L(0); PG8_MMA(0, 1, At, B1); PG8_BAR;
            PG8_LDA(At, 1, 1); PG8_STAGE(PG8_SA(1, 0), a3, voffA);
            PG8_BAR; PG8_WAIT_L(0); PG8_MMA(1, 0, At, B0); PG8_BAR; PG8_SCHED;
            PG8_STAGE(PG8_SB(1, 1), b3 + hstep, voffB);
            PG8_WAIT_V(6); PG8_BAR; PG8_MMA(1, 1, At, B1); PG8_BAR;
            }
        }
        if constexpr (ALIGN_EPI) { if (wr == 0) PG8_BAR; }
        if constexpr (!Epi::AFTER_DRAIN) { E(acc, cur, wr, wc, fr, fq); S.done(cur); }
        if (!has_next) break;
#pragma unroll
        for (int a = 0; a < 2; ++a)
#pragma unroll
            for (int b = 0; b < 2; ++b)
#pragma unroll
                for (int m = 0; m < 4; ++m)
#pragma unroll
                    for (int n = 0; n < 2; ++n) acc[a][b][m][n] = (f32x4){0.f, 0.f, 0.f, 0.f};
        cur = nxt; cA = nA; cB = nB; ++ui;
        if constexpr (ALIGN_EPI) { if (wr == 1) PG8_BAR; }
    }
    PG8_WAIT_V(0);
    if constexpr (!ALIGN_EPI) { if (wr == 0) PG8_BAR; }
    PG8_BAR;
    if constexpr (Epi::AFTER_DRAIN) { E.fused(acc, cur, wr, wc, fr, fq, lds, wid, lane); S.done(cur); }
#undef PG8_SA
#undef PG8_SB
#undef PG8_STAGE
#undef PG8_LDA
#undef PG8_LDB
#undef PG8_MMA
#undef PG8_WAIT_V
#undef PG8_WAIT_L
#undef PG8_BAR
#undef PG8_SCHED
}
}

enum { EPI_INPROJ = 0, EPI_RES = 1, EPI_SWIGLU = 2, EPI_F32 = 3, EPI_KV = 4, EPI_BF16 = 5 };
template <int MODE> struct Epi {
    static constexpr bool PERM = (MODE != EPI_RES && MODE != EPI_F32), AFTER_DRAIN = false;
    const float* res; float* outf; int ldo; bf16_t* o0; bf16_t* o1; bf16_t* o2;
    DI void operator()(const f32x4 (&acc)[2][2][4][2], const pg8::Unit& u, int wr, int wc, int fr, int fq) const {
#pragma unroll
        for (int ai = 0; ai < 2; ++ai)
#pragma unroll
            for (int m = 0; m < 4; ++m) {
                const int r = u.pm * 256 + ai * 128 + wr * 64 + m * 16 + fr;
                if (MODE == EPI_SWIGLU) {
                    const f32x4 g0 = acc[ai][0][m][0], g1 = acc[ai][0][m][1], u0 = acc[ai][1][m][0], u1 = acc[ai][1][m][1];
#define SWG(g, u) nopack(nopack(siluf(nopack(g))) * (u))
                    u32x4 w; w.x = pack2(SWG(g0[0], u0[0]), SWG(g0[1], u0[1])); w.y = pack2(SWG(g0[2], u0[2]), SWG(g0[3], u0[3]));
                    w.z = pack2(SWG(g1[0], u1[0]), SWG(g1[1], u1[1])); w.w = pack2(SWG(g1[2], u1[2]), SWG(g1[3], u1[3]));
#undef SWG
                    *(u32x4*)(o0 + (size_t)r * 2816 + u.pn * 128 + wc * 32 + fq * 8) = w;
                } else {
#pragma unroll
                    for (int bj = 0; bj < 2; ++bj) {
                        if (!PERM) {
#pragma unroll
                            for (int n = 0; n < 2; ++n) {
                                const int c = u.pn * 256 + bj * 128 + wc * 32 + n * 16 + fq * 4; const f32x4 a = acc[ai][bj][m][n];
                                if (MODE == EPI_RES) { const size_t off = (size_t)r * 1024 + c; const f32x4 rv = *(const f32x4*)(res + off); *(f32x4*)(outf + off) = rv + a; }
                                else { *(f32x4*)(outf + (size_t)r * ldo + c) = a; }
                            }
                        } else {
                            const int cl = bj * 128 + wc * 32 + fq * 8; const int c = u.pn * 256 + cl; const f32x4 a0 = acc[ai][bj][m][0], a1 = acc[ai][bj][m][1];
                            if (MODE == EPI_INPROJ) {
                                if (u.pn < 4) { u32x4 w; w.x = pack2(a0[0], a0[1]); w.y = pack2(a0[2], a0[3]); w.z = pack2(a1[0], a1[1]); w.w = pack2(a1[2], a1[3]); *(u32x4*)(o0 + (size_t)r * 1024 + c) = w; }
                                else if (u.pn < 8) { const int h = u.pn - 4, ch = r >> 6, jx = r & 63; bf16_t* vp = o1 + ((size_t)(ch * 4 + h) * 256 + cl) * 64 + jx;
#pragma unroll
                                    for (int e = 0; e < 4; ++e) { vp[e * 64] = f2bf(a0[e]); vp[(e + 4) * 64] = f2bf(a1[e]); } }
                                else { u32x4 w; w.x = pack2(nopack(siluf(nopack(a0[0]))), nopack(siluf(nopack(a0[1])))); w.y = pack2(nopack(siluf(nopack(a0[2]))), nopack(siluf(nopack(a0[3])))); w.z = pack2(nopack(siluf(nopack(a1[0]))), nopack(siluf(nopack(a1[1])))); w.w = pack2(nopack(siluf(nopack(a1[2]))), nopack(siluf(nopack(a1[3]))));
                                    *(u32x4*)(o2 + (size_t)r * 1024 + (c - 2048)) = w; }
                            } else if (MODE == EPI_KV) {
                                const int head = u.pn * 2 + bj, hc = wc * 32 + fq * 8;
                                if (wc < 2) { u32x4 w; w.x = pack2(a0[0], a0[1]); w.y = pack2(a0[2], a0[3]); w.z = pack2(a1[0], a1[1]); w.w = pack2(a1[2], a1[3]); *(u32x4*)(o0 + ((size_t)r * 16 + head) * 96 + hc) = w; }
                                else { bf16_t* vp = o1 + ((size_t)head * 64 + (hc - 64)) * S + r;
#pragma unroll
                                    for (int e = 0; e < 4; ++e) { vp[(size_t)e * S] = f2bf(a0[e]); vp[(size_t)(e + 4) * S] = f2bf(a1[e]); } }
                            } else {
                                u32x4 w; w.x = pack2(a0[0], a0[1]); w.y = pack2(a0[2], a0[3]); w.z = pack2(a1[0], a1[1]); w.w = pack2(a1[2], a1[3]); *(u32x4*)(o0 + (size_t)r * ldo + c) = w;
                            }
                        }
                    }
                }
                asm volatile("" ::: "memory");
            }
    }
};
template <int MODE>
DI void gemm_phase(const bf16_t* A, const bf16_t* Bt, int N, int K, const Epi<MODE>& E, char* smem) {
    asm volatile("" : "+s"(K));
    pg8::Gemm g{A, Bt, S, N, K}; pg8::StaticOrder so; so.init(S, N, (int)gridDim.x, (int)blockIdx.x);
    pg8::gemm_phase<Epi<MODE>, pg8::StaticOrder, true, true>((PG8_LAS unsigned char*)smem, g, so, E);
}

struct EpiResNorm {
    static constexpr bool PERM = false, AFTER_DRAIN = true;
    const float* res; float* outf; bf16_t* xh; float* xbuf; unsigned* cnt;
    DI void operator()(const f32x4 (&)[2][2][4][2], const pg8::Unit&, int, int, int, int) const {}
    DI void fused(f32x4 (&acc)[2][2][4][2], const pg8::Unit& u, int wr, int wc, int fr, int fq, PG8_LAS unsigned char* lds, int wid, int lane) const {
        PG8_LAS float* P = (PG8_LAS float*)lds; PG8_LAS float* Sr = (PG8_LAS float*)(lds + 4096);
        const int tid = wid * 64 + lane;
#pragma unroll
        for (int ai = 0; ai < 2; ++ai)
#pragma unroll
            for (int m = 0; m < 4; ++m) {
                const int rl = ai * 128 + wr * 64 + m * 16 + fr; const size_t rowoff = (size_t)(u.pm * 256 + rl) * 1024 + u.pn * 256 + wc * 32 + fq * 4; float ss = 0.f;
#pragma unroll
                for (int bj = 0; bj < 2; ++bj)
#pragma unroll
                    for (int n = 0; n < 2; ++n) { const f32x4 v = *(const f32x4*)(res + rowoff + bj * 128 + n * 16) + acc[ai][bj][m][n]; acc[ai][bj][m][n] = v; ss += v[0] * v[0] + v[1] * v[1] + v[2] * v[2] + v[3] * v[3]; }
                ss += __shfl_xor(ss, 16); ss += __shfl_xor(ss, 32);
                if (fq == 0) P[rl * 4 + wc] = ss;
                asm volatile("" ::: "memory");
            }
        __syncthreads();
        if (tid < 256) {
            const float tot = (P[tid * 4] + P[tid * 4 + 1]) + (P[tid * 4 + 2] + P[tid * 4 + 3]);
            __hip_atomic_store(xbuf + (size_t)(u.pm * 256 + tid) * 4 + u.pn, tot, __ATOMIC_RELAXED, __HIP_MEMORY_SCOPE_AGENT);
            asm volatile("s_waitcnt vmcnt(0)" ::: "memory");
            if (lane == 0) __hip_atomic_fetch_add(cnt + 64 * u.pm, 1u, __ATOMIC_RELAXED, __HIP_MEMORY_SCOPE_AGENT);
        }
        if (wid == 0) {
            unsigned sp = 0u;
            while (__hip_atomic_load(cnt + 64 * u.pm, __ATOMIC_RELAXED, __HIP_MEMORY_SCOPE_AGENT) < 16u) { __builtin_amdgcn_s_sleep(1); if (++sp > (1u << 22)) break; }
            __builtin_amdgcn_fence(__ATOMIC_ACQUIRE, "agent");
            asm volatile("s_waitcnt vmcnt(0)" ::: "memory");
        }
        __syncthreads();
        if (tid < 256) {
            const float* sl = xbuf + (size_t)(u.pm * 256 + tid) * 4;
            const float t = (__hip_atomic_load(sl, __ATOMIC_RELAXED, __HIP_MEMORY_SCOPE_AGENT) + __hip_atomic_load(sl + 1, __ATOMIC_RELAXED, __HIP_MEMORY_SCOPE_AGENT))
                          + (__hip_atomic_load(sl + 2, __ATOMIC_RELAXED, __HIP_MEMORY_SCOPE_AGENT) + __hip_atomic_load(sl + 3, __ATOMIC_RELAXED, __HIP_MEMORY_SCOPE_AGENT));
            Sr[tid] = rsqrtf(t * (1.f / 1024.f) + EPS);
        }
        __syncthreads();
#pragma unroll
        for (int ai = 0; ai < 2; ++ai)
#pragma unroll
            for (int m = 0; m < 4; ++m) {
                const int rl = ai * 128 + wr * 64 + m * 16 + fr; const size_t rowoff = (size_t)(u.pm * 256 + rl) * 1024 + u.pn * 256 + wc * 32 + fq * 4; const float rstd = Sr[rl];
#pragma unroll
                for (int bj = 0; bj < 2; ++bj)
#pragma unroll
                    for (int n = 0; n < 2; ++n) { const f32x4 v = acc[ai][bj][m][n]; const size_t off = rowoff + bj * 128 + n * 16; *(f32x4*)(outf + off) = v;
                        u32x2 w; w.x = pack2(v[0] * rstd, v[1] * rstd); w.y = pack2(v[2] * rstd, v[3] * rstd); *(u32x2*)(xh + off) = w; }
                asm volatile("" ::: "memory");
            }
    }
};
struct EpiLatent {
    static constexpr bool PERM = false, AFTER_DRAIN = true;
    bf16_t* ckv; bf16_t* cq; float* krope; float* xbuf; unsigned* cnt; const float* ropet; const float* kgain; float* krss;
    DI void operator()(const f32x4 (&)[2][2][4][2], const pg8::Unit&, int, int, int, int) const {}
    DI void fused(f32x4 (&acc)[2][2][4][2], const pg8::Unit& u, int wr, int wc, int fr, int fq, PG8_LAS unsigned char* lds, int wid, int lane) const {
        PG8_LAS float* P = (PG8_LAS float*)lds; PG8_LAS float* Sr = (PG8_LAS float*)(lds + 4096);
        const int tid = wid * 64 + lane;
#pragma unroll
        for (int ai = 0; ai < 2; ++ai)
#pragma unroll
            for (int m = 0; m < 4; ++m) {
                const int rl = ai * 128 + wr * 64 + m * 16 + fr; float ss = 0.f;
#pragma unroll
                for (int bj = 0; bj < 2; ++bj)
#pragma unroll
                    for (int n = 0; n < 2; ++n) { const f32x4 v = acc[ai][bj][m][n]; const float q = v[0] * v[0] + v[1] * v[1] + v[2] * v[2] + v[3] * v[3]; if (bj == 0 || u.pn != 2) ss += q; }
                ss += __shfl_xor(ss, 16); ss += __shfl_xor(ss, 32);
                if (fq == 0) P[rl * 4 + wc] = ss;
            }
        __syncthreads();
        if (u.pn != 0) {
            if (tid < 256) {
                const float tot = (P[tid * 4] + P[tid * 4 + 1]) + (P[tid * 4 + 2] + P[tid * 4 + 3]);
                __hip_atomic_store(xbuf + (size_t)(u.pm * 256 + tid) * 2 + (u.pn - 1), tot, __ATOMIC_RELAXED, __HIP_MEMORY_SCOPE_AGENT);
                asm volatile("s_waitcnt vmcnt(0)" ::: "memory");
                if (lane == 0) __hip_atomic_fetch_add(cnt + 64 * u.pm, 1u, __ATOMIC_RELAXED, __HIP_MEMORY_SCOPE_AGENT);
            }
            if (wid == 0) {
                unsigned sp = 0u;
                while (__hip_atomic_load(cnt + 64 * u.pm, __ATOMIC_RELAXED, __HIP_MEMORY_SCOPE_AGENT) < 8u) { __builtin_amdgcn_s_sleep(1); if (++sp > (1u << 22)) break; }
                __builtin_amdgcn_fence(__ATOMIC_ACQUIRE, "agent");
                asm volatile("s_waitcnt vmcnt(0)" ::: "memory");
            }
            __syncthreads();
            if (tid < 256) {
                const float* sl = xbuf + (size_t)(u.pm * 256 + tid) * 2;
                const float t = __hip_atomic_load(sl, __ATOMIC_RELAXED, __HIP_MEMORY_SCOPE_AGENT) + __hip_atomic_load(sl + 1, __ATOMIC_RELAXED, __HIP_MEMORY_SCOPE_AGENT);
                Sr[tid] = rsqrtf(t * (1.f / 384.f) + EPS);
            }
        } else {
            if (tid < 256) Sr[tid] = rsqrtf(((P[tid * 4] + P[tid * 4 + 1]) + (P[tid * 4 + 2] + P[tid * 4 + 3])) * (1.f / 256.f) + EPS);
        }
        __syncthreads();
#pragma unroll
        for (int ai = 0; ai < 2; ++ai)
#pragma unroll
            for (int m = 0; m < 4; ++m) {
                const int rl = ai * 128 + wr * 64 + m * 16 + fr; const size_t r = (size_t)(u.pm * 256 + rl); const float rstd = Sr[rl];
#pragma unroll
                for (int bj = 0; bj < 2; ++bj)
#pragma unroll
                    for (int n = 0; n < 2; ++n) {
                        const f32x4 v = acc[ai][bj][m][n]; const int cl = bj * 128 + wc * 32 + n * 16 + fq * 4;
                        u32x2 w; w.x = pack2(v[0] * rstd, v[1] * rstd); w.y = pack2(v[2] * rstd, v[3] * rstd);
                        if (u.pn == 0) *(u32x2*)(ckv + r * 256 + cl) = w;
                        else if (u.pn == 1) *(u32x2*)(cq + r * 384 + cl) = w;
                        else if (bj == 0) *(u32x2*)(cq + r * 384 + 256 + cl) = w;
                    }
                if (u.pn == 2 && wc == 0) {
                    const f32x4 v0 = acc[ai][1][m][0], v1 = acc[ai][1][m][1];
                    float q = (v0[0] * v0[0] + v0[1] * v0[1] + v0[2] * v0[2] + v0[3] * v0[3]) + (v1[0] * v1[0] + v1[1] * v1[1] + v1[2] * v1[2] + v1[3] * v1[3]);
                    q += __shfl_xor(q, 16); q += __shfl_xor(q, 32);
                    if (fq == 0) krss[r] = q;
                    const f32x4 g1 = *(const f32x4*)(kgain + 64 + 4 * fq), g2 = *(const f32x4*)(kgain + 80 + 4 * fq);
                    const f32x4 cs = *(const f32x4*)(ropet + r * 32 + 4 * fq), sn = *(const f32x4*)(ropet + r * 32 + 16 + 4 * fq);
                    const f32x4 x1 = v0 * g1, x2 = v1 * g2;
                    *(f32x4*)(krope + r * 32 + 4 * fq) = x1 * cs - x2 * sn; *(f32x4*)(krope + r * 32 + 16 + 4 * fq) = x1 * sn + x2 * cs;
                }
                asm volatile("" ::: "memory");
            }
    }
};
DI void gemm_phase_latent(const bf16_t* A, const bf16_t* Bt, const EpiLatent& E, char* smem) {
    int K = 1024; asm volatile("" : "+s"(K));
    pg8::Gemm g{A, Bt, S, 768, K}; pg8::StaticOrder so; so.init(S, 768, (int)gridDim.x, (int)blockIdx.x);
    pg8::gemm_phase<EpiLatent, pg8::StaticOrder, false, true>((PG8_LAS unsigned char*)smem, g, so, E);
}
struct EpiKV2 {
    static constexpr bool PERM = true, AFTER_DRAIN = false;
    bf16_t* kb; bf16_t* vt; const float* krss; const float* krope;
    DI void operator()(const f32x4 (&acc)[2][2][4][2], const pg8::Unit& u, int wr, int wc, int fr, int fq) const {
        const int head = u.pn * 2 + (wc >> 1);
#pragma unroll
        for (int ai = 0; ai < 2; ++ai)
#pragma unroll
            for (int m = 0; m < 4; ++m) {
                const int r = u.pm * 256 + ai * 128 + wr * 64 + m * 16 + fr;
                if ((wc & 1) == 0) {
                    float ss = 0.f;
#pragma unroll
                    for (int bj = 0; bj < 2; ++bj)
#pragma unroll
                        for (int n = 0; n < 2; ++n) { const f32x4 v = acc[ai][bj][m][n]; ss += v[0] * v[0] + v[1] * v[1] + v[2] * v[2] + v[3] * v[3]; }
                    ss += __shfl_xor(ss, 16); ss += __shfl_xor(ss, 32);
                    const float rstd = rsqrtf((ss + krss[r]) * (1.f / 96.f) + EPS);
                    bf16_t* kp = kb + ((size_t)r * 16 + head) * 96;
#pragma unroll
                    for (int bj = 0; bj < 2; ++bj) { const f32x4 a0 = acc[ai][bj][m][0] * rstd, a1 = acc[ai][bj][m][1] * rstd;
                        u32x4 w; w.x = pack2(a0[0], a0[1]); w.y = pack2(a0[2], a0[3]); w.z = pack2(a1[0], a1[1]); w.w = pack2(a1[2], a1[3]); *(u32x4*)(kp + bj * 32 + fq * 8) = w; }
                    const f32x4 k0 = *(const f32x4*)(krope + (size_t)r * 32 + fq * 8) * rstd, k1 = *(const f32x4*)(krope + (size_t)r * 32 + fq * 8 + 4) * rstd;
                    u32x4 w; w.x = pack2(k0[0], k0[1]); w.y = pack2(k0[2], k0[3]); w.z = pack2(k1[0], k1[1]); w.w = pack2(k1[2], k1[3]); *(u32x4*)(kp + 64 + fq * 8) = w;
                } else {
#pragma unroll
                    for (int bj = 0; bj < 2; ++bj) { const f32x4 a0 = acc[ai][bj][m][0], a1 = acc[ai][bj][m][1]; bf16_t* vp = vt + ((size_t)head * 64 + bj * 32 + fq * 8) * S + r;
#pragma unroll
                        for (int e = 0; e < 4; ++e) { vp[(size_t)e * S] = f2bf(a0[e]); vp[(size_t)(e + 4) * S] = f2bf(a1[e]); } }
                }
                asm volatile("" ::: "memory");
            }
    }
};
DI void gemm_phase_kv2(const bf16_t* A, const bf16_t* Bt, const EpiKV2& E, char* smem) {
    int K = 256; asm volatile("" : "+s"(K));
    pg8::Gemm g{A, Bt, S, 2048, K}; pg8::StaticOrder so; so.init(S, 2048, (int)gridDim.x, (int)blockIdx.x);
    pg8::gemm_phase<EpiKV2, pg8::StaticOrder, true, true>((PG8_LAS unsigned char*)smem, g, so, E);
}
DI void gemm_phase_resnorm(const bf16_t* A, const bf16_t* Bt, int K, const EpiResNorm& E, char* smem) {
    asm volatile("" : "+s"(K));
    pg8::Gemm g{A, Bt, S, 1024, K}; pg8::StaticOrder so; so.init(S, 1024, (int)gridDim.x, (int)blockIdx.x);
    pg8::gemm_phase<EpiResNorm, pg8::StaticOrder, false, true>((PG8_LAS unsigned char*)smem, g, so, E);
}

DI void gla_gate(const Params& p, int n, int h, float* gl_s, float* tot_s, float (&bcum)[32], float& blast) {
    const int tid = tid_fresh() & 255, c = tid & 127, hf = tid >> 7;
    const float* glp = (const float*)(p.ws + GL) + (size_t)n * 64 * 16;
    *(f32x4*)(gl_s + tid * 4) = *(const f32x4*)(glp + tid * 4);
    float wgu[16];
#pragma unroll
    for (int r = 0; r < 16; ++r) wgu[r] = p.a_w_gate_up[r * 512 + h * 128 + c];
    const float bias = p.a_b_gate[h * 128 + c];
    __syncthreads();
    float cum = 0.f;
#pragma unroll
    for (int i = 0; i < 32; ++i) {
        const f32x4* gr = (const f32x4*)(gl_s + (hf * 32 + i) * 16); float z = bias;
#pragma unroll
        for (int r4 = 0; r4 < 4; ++r4) { const f32x4 g = gr[r4];
#pragma unroll
            for (int e = 0; e < 4; ++e) { z = __builtin_fmaf(g[e], wgu[r4 * 4 + e], z); asm("" : "+v"(z)); } }
        const float ls = fminf(z, 0.f) - __logf(1.f + __expf(-fabsf(z)));
        cum += ls * (1.f / 16.f); bcum[i] = cum;
    }
    tot_s[hf * 128 + c] = cum;
    __syncthreads();
    const float t0 = tot_s[c], t1 = tot_s[128 + c];
    if (hf) {
#pragma unroll
        for (int i = 0; i < 32; ++i) bcum[i] += t0;
    }
    blast = t0 + t1;
}

DI void gla_kv_unit(const Params& p, int u, char* smem) {
    float* gl_s = (float*)smem; float* tot_s = gl_s + 1024; bf16_t* kend_s = (bf16_t*)(tot_s + 256);
    const int tid = tid_fresh() & 255, c = tid & 127, hf = tid >> 7, lane = tid & 63, w = tid >> 6, lr = lane & 15, lq = lane >> 4;
    const int n = u >> 2, h = u & 3;
    float bcum[32], blast; gla_gate(p, n, h, gl_s, tot_s, bcum, blast);
    const bf16_t* kp = (const bf16_t*)(p.ws + QK) + (size_t)(n * 64 + hf * 32) * 1024 + 512 + h * 128 + c;
    unsigned pk[16];
#pragma unroll
    for (int i = 0; i < 32; i += 2) {
        const float k0 = bf2f(kp[(size_t)i * 1024]), k1 = bf2f(kp[(size_t)(i + 1) * 1024]);
        pk[i >> 1] = pack2(k0 * __expf(blast - bcum[i]), k1 * __expf(blast - bcum[i + 1]));
    }
    u32x4* dst = (u32x4*)(kend_s + c * 72 + hf * 32);
#pragma unroll
    for (int i = 0; i < 4; ++i) dst[i] = (u32x4){pk[4 * i], pk[4 * i + 1], pk[4 * i + 2], pk[4 * i + 3]};
    if (hf == 0) ((float*)(p.ws + DEC))[(size_t)u * 128 + c] = __expf(blast);
    __syncthreads();
    const int dv0 = w * 64;
    const bf16_t* vt = (const bf16_t*)(p.ws + VT) + ((size_t)u * 256 + dv0) * 64;
    bf16x8 vf[4][2];
#pragma unroll
    for (int mt = 0; mt < 4; ++mt)
#pragma unroll
        for (int kk = 0; kk < 2; ++kk) vf[mt][kk] = *(const bf16x8*)(vt + (mt * 16 + lr) * 64 + kk * 32 + lq * 8);
    bf16_t* kvo = (bf16_t*)(p.ws + KVT) + (size_t)u * 256 * 128;
#pragma unroll
    for (int half = 0; half < 2; ++half) {
        f32x4 acc[4][4];
#pragma unroll
        for (int a = 0; a < 4; ++a)
#pragma unroll
            for (int b = 0; b < 4; ++b) acc[a][b] = (f32x4){0.f, 0.f, 0.f, 0.f};
#pragma unroll
        for (int kk = 0; kk < 2; ++kk)
#pragma unroll
            for (int nt = 0; nt < 4; ++nt) {
                const bf16x8 kf = *(const bf16x8*)(kend_s + ((half * 4 + nt) * 16 + lr) * 72 + kk * 32 + lq * 8);
#pragma unroll
                for (int mt = 0; mt < 4; ++mt) acc[nt][mt] = mfma16(kf, vf[mt][kk], acc[nt][mt]);
            }
#pragma unroll
        for (int nt = 0; nt < 4; ++nt)
#pragma unroll
            for (int mt = 0; mt < 4; ++mt) {
                const int dk = (half * 4 + nt) * 16 + lq * 4, dv = dv0 + mt * 16 + lr; const f32x4 a = acc[nt][mt];
                u32x2 wv; wv.x = pack2(a[0], a[1]); wv.y = pack2(a[2], a[3]); *(u32x2*)(kvo + (size_t)dv * 128 + dk) = wv;
            }
    }
    __syncthreads();
}

DI void gla_scan(const Params& p) {
    const int gt = blockIdx.x * NT + tid_fresh(), nth = gridDim.x * NT;
    for (int e = gt; e < 131072; e += nth) {
        const int h = e >> 15, dk = e & 127;
        bf16_t* kv = (bf16_t*)(p.ws + KVT) + e; const float* dec = (const float*)(p.ws + DEC) + h * 128 + dk;
        float s0 = 0.f;
        for (int n = 0; n < 256; n += 16) {
            bf16_t v[16]; float d[16];
#pragma unroll
            for (int q = 0; q < 16; ++q) { v[q] = kv[(size_t)(n + q) * 131072]; d[q] = dec[(size_t)(n + q) * 512]; }
#pragma unroll
            for (int q = 0; q < 16; ++q) { kv[(size_t)(n + q) * 131072] = f2bf(s0); s0 = d[q] * s0 + bf2f(v[q]); }
        }
    }
}

DI void gla_out_unit(const Params& p, int u, char* smem) {
    float* gl_s = (float*)smem; float* tot_s = gl_s + 1024; float* ss_s = tot_s + 256; bf16_t* qdec_s = (bf16_t*)(ss_s + 256);
    bf16_t* kinv_s = qdec_s + 64 * 136; bf16_t* attn_s = kinv_s + 64 * 136;
    const int tid = tid_fresh() & 255, c = tid & 127, hf = tid >> 7, lane = tid & 63, w = tid >> 6, lr = lane & 15, lq = lane >> 4;
    const int n = u >> 2, h = u & 3;
    float bcum[32], blast; gla_gate(p, n, h, gl_s, tot_s, bcum, blast);
    {
        const bf16_t* qp = (const bf16_t*)(p.ws + QK) + (size_t)(n * 64 + hf * 32) * 1024 + h * 128 + c;
#pragma unroll
        for (int i = 0; i < 32; ++i) {
            const float q = bf2f(qp[(size_t)i * 1024]), k = bf2f(qp[(size_t)i * 1024 + 512]);
            const int row = hf * 32 + i;
            qdec_s[row * 136 + c] = f2bf(q * 0.08838834764831845f * __expf(bcum[i]));
            kinv_s[row * 136 + c] = f2bf(k * __expf(-bcum[i]));
        }
    }
    __syncthreads();
    {
        bf16x8 qf[4];
#pragma unroll
        for (int kk = 0; kk < 4; ++kk) qf[kk] = *(const bf16x8*)(qdec_s + (w * 16 + lr) * 136 + kk * 32 + lq * 8);
#pragma unroll
        for (int jt = 0; jt < 4; ++jt) {
            f32x4 a = (f32x4){0.f, 0.f, 0.f, 0.f};
            if (jt <= w) {
#pragma unroll
                for (int kk = 0; kk < 4; ++kk) { const bf16x8 kf = *(const bf16x8*)(kinv_s + (jt * 16 + lr) * 136 + kk * 32 + lq * 8); a = mfma16(kf, qf[kk], a); }
            }
            const int i = w * 16 + lr, j0 = jt * 16 + lq * 4;
#pragma unroll
            for (int jj = 0; jj < 4; ++jj) if (j0 + jj > i) a[jj] = 0.f;
            u32x2 wv; wv.x = pack2(a[0], a[1]); wv.y = pack2(a[2], a[3]); *(u32x2*)(attn_s + i * 72 + j0) = wv;
        }
    }
    __syncthreads();
    f32x4 acc[4][4];
#pragma unroll
    for (int a = 0; a < 4; ++a)
#pragma unroll
        for (int b = 0; b < 4; ++b) acc[a][b] = (f32x4){0.f, 0.f, 0.f, 0.f};
    const int dv0 = w * 64;
    {
        const bf16_t* vt = (const bf16_t*)(p.ws + VT) + ((size_t)u * 256 + dv0) * 64;
#pragma unroll
        for (int kk = 0; kk < 2; ++kk) {
            bf16x8 af[4];
#pragma unroll
            for (int it = 0; it < 4; ++it) af[it] = *(const bf16x8*)(attn_s + (it * 16 + lr) * 72 + kk * 32 + lq * 8);
#pragma unroll
            for (int dt = 0; dt < 4; ++dt) { const bf16x8 vf = *(const bf16x8*)(vt + (dt * 16 + lr) * 64 + kk * 32 + lq * 8);
#pragma unroll
                for (int it = 0; it < 4; ++it) acc[dt][it] = mfma16(vf, af[it], acc[dt][it]); }
        }
        const bf16_t* sp = (const bf16_t*)(p.ws + KVT) + ((size_t)u * 256 + dv0) * 128;
#pragma unroll
        for (int kk = 0; kk < 4; ++kk) {
            bf16x8 qf[4];
#pragma unroll
            for (int it = 0; it < 4; ++it) qf[it] = *(const bf16x8*)(qdec_s + (it * 16 + lr) * 136 + kk * 32 + lq * 8);
#pragma unroll
            for (int dt = 0; dt < 4; ++dt) { const bf16x8 sf = *(const bf16x8*)(sp + (dt * 16 + lr) * 128 + kk * 32 + lq * 8);
#pragma unroll
                for (int it = 0; it < 4; ++it) acc[dt][it] = mfma16(sf, qf[it], acc[dt][it]); }
        }
    }
#pragma unroll
    for (int it = 0; it < 4; ++it) {
        float ss = 0.f;
#pragma unroll
        for (int dt = 0; dt < 4; ++dt) { const f32x4 a = acc[dt][it]; ss += a[0] * a[0] + a[1] * a[1] + a[2] * a[2] + a[3] * a[3]; }
        ss += __shfl_xor(ss, 16); ss += __shfl_xor(ss, 32);
        if (lq == 0) ss_s[w * 64 + it * 16 + lr] = ss;
    }
    __syncthreads();
    const bf16_t* rb = (const bf16_t*)(p.ws + RB); bf16_t* og = (bf16_t*)(p.ws + XH);
#pragma unroll
    for (int it = 0; it < 4; ++it) {
        const int i = it * 16 + lr; const float tot = ss_s[i] + ss_s[64 + i] + ss_s[128 + i] + ss_s[192 + i];
        const float rstd = rsqrtf(tot * (1.f / 256.f) + EPS);
        const size_t rowoff = (size_t)(n * 64 + i) * 1024 + h * 256;
#pragma unroll
        for (int dt = 0; dt < 4; ++dt) {
            const int dv = dv0 + dt * 16 + lq * 4; const f32x4 gn = *(const f32x4*)(p.a_out_norm + dv); const u32x2 rr = *(const u32x2*)(rb + rowoff + dv); const f32x4 a = acc[dt][it];
            u32x2 wv; wv.x = pack2(a[0] * rstd * gn[0] * bflo(rr.x), a[1] * rstd * gn[1] * bfhi(rr.x)); wv.y = pack2(a[2] * rstd * gn[2] * bflo(rr.y), a[3] * rstd * gn[3] * bfhi(rr.y));
            *(u32x2*)(og + rowoff + dv) = wv;
        }
    }
    __syncthreads();
}

DI void latent_norm_phase(const Params& p) {
    const int tidf = tid_fresh(); const int lane = tidf & 63; const int gw = (blockIdx.x * NT + tidf) >> 6, nw = (gridDim.x * NT) >> 6;
    for (int s = gw; s < S; s += nw) {
        const float* d = (const float*)(p.ws + DBUF) + (size_t)s * 768;
        const f32x4 a = *(const f32x4*)(d + lane * 4);
        f32x2 b[3];
#pragma unroll
        for (int i = 0; i < 3; ++i) b[i] = *(const f32x2*)(d + 256 + i * 128 + lane * 2);
        float kr = 0.f; if (lane < 32) kr = d[640 + lane];
        float s1 = a[0] * a[0] + a[1] * a[1] + a[2] * a[2] + a[3] * a[3];
        float s2 = b[0].x * b[0].x + b[0].y * b[0].y + b[1].x * b[1].x + b[1].y * b[1].y + b[2].x * b[2].x + b[2].y * b[2].y;
#pragma unroll
        for (int o = 32; o >= 1; o >>= 1) { s1 += __shfl_xor(s1, o); s2 += __shfl_xor(s2, o); }
        const float r1 = rsqrtf(s1 * (1.f / 256.f) + EPS), r2 = rsqrtf(s2 * (1.f / 384.f) + EPS);
        u32x2 wv; wv.x = pack2(a[0] * r1, a[1] * r1); wv.y = pack2(a[2] * r1, a[3] * r1);
        *(u32x2*)((bf16_t*)(p.ws + CKV) + (size_t)s * 256 + lane * 4) = wv;
#pragma unroll
        for (int i = 0; i < 3; ++i) *(unsigned*)((bf16_t*)(p.ws + CQ) + (size_t)s * 384 + i * 128 + lane * 2) = pack2(b[i].x * r2, b[i].y * r2);
        if (lane < 32) ((float*)(p.ws + KROPE))[(size_t)s * 32 + lane] = kr;
    }
}

DI void qk_post_phase(const Params& p) {
    const int gt = blockIdx.x * NT + tid_fresh(), nth = gridDim.x * NT;
    for (int idx = gt; idx < 2 * S * 16; idx += nth) {
        const int isk = idx >= S * 16; const int id = isk ? idx - S * 16 : idx; const int s = id >> 4;
        bf16_t* vp = (bf16_t*)(p.ws + (isk ? KB : QB)) + (size_t)id * 96;
        const float* gain = isk ? p.k_norm : p.b_q_norm;
        float v[96];
#pragma unroll
        for (int i = 0; i < 8; ++i) { const u32x4 t = *(const u32x4*)(vp + i * 8);
            v[i * 8 + 0] = bflo(t.x); v[i * 8 + 1] = bfhi(t.x); v[i * 8 + 2] = bflo(t.y); v[i * 8 + 3] = bfhi(t.y); v[i * 8 + 4] = bflo(t.z); v[i * 8 + 5] = bfhi(t.z); v[i * 8 + 6] = bflo(t.w); v[i * 8 + 7] = bfhi(t.w); }
        if (isk) {
            const float* kr = (const float*)(p.ws + KROPE) + (size_t)s * 32;
#pragma unroll
            for (int i = 0; i < 8; ++i) { const f32x4 t = *(const f32x4*)(kr + i * 4); v[64 + i * 4] = t[0]; v[65 + i * 4] = t[1]; v[66 + i * 4] = t[2]; v[67 + i * 4] = t[3]; }
        } else {
#pragma unroll
            for (int i = 8; i < 12; ++i) { const u32x4 t = *(const u32x4*)(vp + i * 8);
                v[i * 8 + 0] = bflo(t.x); v[i * 8 + 1] = bfhi(t.x); v[i * 8 + 2] = bflo(t.y); v[i * 8 + 3] = bfhi(t.y); v[i * 8 + 4] = bflo(t.z); v[i * 8 + 5] = bfhi(t.z); v[i * 8 + 6] = bflo(t.w); v[i * 8 + 7] = bfhi(t.w); }
        }
        float ss = 0.f;
#pragma unroll
        for (int i = 0; i < 96; ++i) ss += v[i] * v[i];
        const float r = rsqrtf(ss * (1.f / 96.f) + EPS);
#pragma unroll
        for (int i = 0; i < 96; ++i) v[i] = v[i] * r * gain[i];
        const float* rt = (const float*)(p.ws + ROPET) + (size_t)s * 32;
#pragma unroll
        for (int i4 = 0; i4 < 4; ++i4) {
            const f32x4 cs = *(const f32x4*)(rt + i4 * 4), sn = *(const f32x4*)(rt + 16 + i4 * 4);
#pragma unroll
            for (int e = 0; e < 4; ++e) { const int i = i4 * 4 + e; const float x1 = v[64 + i], x2 = v[80 + i]; v[64 + i] = x1 * cs[e] - x2 * sn[e]; v[80 + i] = x1 * sn[e] + x2 * cs[e]; }
        }
        const float osc = isk ? 1.f : 0.14724444302f;
#pragma unroll
        for (int i = 0; i < 12; ++i) { u32x4 t; t.x = pack2(v[i * 8] * osc, v[i * 8 + 1] * osc); t.y = pack2(v[i * 8 + 2] * osc, v[i * 8 + 3] * osc); t.z = pack2(v[i * 8 + 4] * osc, v[i * 8 + 5] * osc); t.w = pack2(v[i * 8 + 6] * osc, v[i * 8 + 7] * osc);
            *(u32x4*)(vp + i * 8) = t; }
    }
}

DI void attn_phase(const Params& p, char* smem, int ctr_idx, bool qpost) {
    bf16_t* Ks = (bf16_t*)smem;
    bf16_t* Vs = Ks + 2 * 128 * 104;
    int* sh_u = (int*)(Vs + 2 * 64 * 136);
    const int tid = tid_fresh(), lane = tid & 63, w = tid >> 6, l31 = lane & 31, lh = lane >> 5;
    const int pi = (l31 & 0x13) | ((l31 & 4) << 1) | ((l31 & 8) >> 1);
    int koff_g[3], koff_l[3];
#pragma unroll
    for (int i = 0; i < 3; ++i) { const int c = tid + 512 * i; const int row = c / 12, part = c - row * 12; koff_g[i] = row * 16 * 96 + part * 8; koff_l[i] = row * 104 + part * 8; }
    const int voff_g0 = (tid >> 4) * S + (tid & 15) * 8, voff_l0 = (tid >> 4) * 136 + (tid & 15) * 8;
#define voff_g(i) (voff_g0 + (i) * 32 * S)
#define voff_l(i) (voff_l0 + (i) * 32 * 136)
    if (tid == 0) sh_u[1] = 0;
    for (int xi = 0; xi < 8; ++xi) {
    const int xq = ((int)(xb_xcc_id() & 7u) + xi) & 7;
    for (;;) {
        if (tid == 0) *sh_u = (int)atomicAdd((unsigned*)(p.ws + MISC) + ctr_idx * 512 + xq * 64, 1u);
        __syncthreads();
        const int u = *sh_u;
        __syncthreads();
        if (u >= 128) break;
        const int qt = 63 - (u >> 1), h = xq * 2 + (u & 1), q0 = qt * 256;
        const int nst = 2 * qt + 2, my_nkt = 4 * qt + 1 + (w >> 1);
        const bool sticky = __builtin_amdgcn_readfirstlane(sh_u[1]) != 0;
        for (int attempt = 0;; ++attempt) {
        const bool trk = sticky || attempt > 0;
        bf16x8 qf[6];
        {
            const bf16_t* qp = (const bf16_t*)(p.ws + QB) + ((size_t)(q0 + w * 32 + l31) * 16 + h) * 96 + lh * 8;
#pragma unroll
            for (int ks = 0; ks < 6; ++ks) qf[ks] = *(const bf16x8*)(qp + ks * 16);
        }
        if (qpost) {
            const int tok = q0 + w * 32 + l31;
            float v[6][8]; float ss = 0.f;
#pragma unroll
            for (int ks = 0; ks < 6; ++ks)
#pragma unroll
                for (int e = 0; e < 8; ++e) { v[ks][e] = bf2f((bf16_t)qf[ks][e]); ss += v[ks][e] * v[ks][e]; }
            ss += __shfl_xor(ss, 32);
            const float rs = rsqrtf(ss * (1.f / 96.f) + EPS);
#pragma unroll
            for (int ks = 0; ks < 6; ++ks) {
                const int d0 = ks * 16 + lh * 8; const f32x4 ga = *(const f32x4*)(p.b_q_norm + d0), gb = *(const f32x4*)(p.b_q_norm + d0 + 4);
#pragma unroll
                for (int e = 0; e < 4; ++e) { v[ks][e] *= rs * ga[e]; v[ks][e + 4] *= rs * gb[e]; }
                if (ks < 4) { const f32x4 ka = *(const f32x4*)(p.k_norm + d0), kb2 = *(const f32x4*)(p.k_norm + d0 + 4);
#pragma unroll
                    for (int e = 0; e < 4; ++e) { v[ks][e] *= ka[e]; v[ks][e + 4] *= kb2[e]; } }
            }
            {
                const float* rt = (const float*)(p.ws + ROPET) + (size_t)tok * 32 + lh * 8;
                const f32x4 c0 = *(const f32x4*)(rt), c1 = *(const f32x4*)(rt + 4), s0 = *(const f32x4*)(rt + 16), s1 = *(const f32x4*)(rt + 20);
#pragma unroll
                for (int e = 0; e < 4; ++e) {
                    { const float x1 = v[4][e], x2 = v[5][e]; v[4][e] = x1 * c0[e] - x2 * s0[e]; v[5][e] = x1 * s0[e] + x2 * c0[e]; }
                    { const float x1 = v[4][e + 4], x2 = v[5][e + 4]; v[4][e + 4] = x1 * c1[e] - x2 * s1[e]; v[5][e + 4] = x1 * s1[e] + x2 * c1[e]; }
                }
            }
            const float osc = 0.14724444302f;
#pragma unroll
            for (int ks = 0; ks < 6; ++ks) { u32x4 t; t.x = pack2(v[ks][0] * osc, v[ks][1] * osc); t.y = pack2(v[ks][2] * osc, v[ks][3] * osc); t.z = pack2(v[ks][4] * osc, v[ks][5] * osc); t.w = pack2(v[ks][6] * osc, v[ks][7] * osc);
                qf[ks] = __builtin_bit_cast(bf16x8, t); }
        }
        f32x16 O0, O1, negm;
#pragma unroll
        for (int i = 0; i < 16; ++i) { O0[i] = 0.f; O1[i] = 0.f; negm[i] = 0.f; }
        float lsum = 0.f;
        const bf16_t* Kh = (const bf16_t*)(p.ws + KB) + h * 96; const bf16_t* Vh = (const bf16_t*)(p.ws + VTM) + (size_t)h * 64 * S;
        u32x4 rk[3], rv[2];
#pragma unroll
        for (int i = 0; i < 3; ++i) rk[i] = *(const u32x4*)(Kh + koff_g[i]);
#pragma unroll
        for (int i = 0; i < 2; ++i) rv[i] = *(const u32x4*)(Vh + voff_g(i));
#pragma unroll
        for (int i = 0; i < 3; ++i) *(u32x4*)(Ks + koff_l[i]) = rk[i];
#pragma unroll
        for (int i = 0; i < 2; ++i) *(u32x4*)(Vs + voff_l(i)) = rv[i];
        __syncthreads();
        for (int st = 0; st < nst; ++st) {
            const int buf = st & 1; const bool more = st + 1 < nst;
            if (more) {
#pragma unroll
                for (int i = 0; i < 3; ++i) rk[i] = *(const u32x4*)(Kh + (size_t)(st + 1) * 128 * 16 * 96 + koff_g[i]);
#pragma unroll
                for (int i = 0; i < 2; ++i) rv[i] = *(const u32x4*)(Vh + (st + 1) * 128 + voff_g(i));
            }
#pragma unroll
            for (int sub = 0; sub < 2; ++sub) {
                const int tile = st * 2 + sub;
                if (tile < my_nkt) {
                    const bf16_t* kb = Ks + buf * 128 * 104 + (sub * 64 + pi) * 104 + lh * 8; const bf16_t* vb = Vs + buf * 64 * 136 + l31 * 136 + sub * 64 + lh * 8;
                    f32x16 s0, s1;
                    bf16x8 kf[12], vf[8];
#pragma unroll
                    for (int ks = 0; ks < 6; ++ks) { kf[2 * ks] = *(const bf16x8*)(kb + ks * 16); kf[2 * ks + 1] = *(const bf16x8*)(kb + 32 * 104 + ks * 16); }
                    __builtin_amdgcn_sched_barrier(0);
#pragma unroll
                    for (int ks = 0; ks < 4; ++ks) { vf[2 * ks] = *(const bf16x8*)(vb + ks * 16); vf[2 * ks + 1] = *(const bf16x8*)(vb + 32 * 136 + ks * 16); }
                    s0 = mfma32(kf[0], qf[0], negm); s1 = mfma32(kf[1], qf[0], negm);
#pragma unroll
                    for (int ks = 1; ks < 6; ++ks) { s0 = mfma32(kf[2 * ks], qf[ks], s0); s1 = mfma32(kf[2 * ks + 1], qf[ks], s1); }
                    __builtin_amdgcn_sched_barrier(0);
                    if (tile == 0 || trk) {
                    float mx = fmaxf(s0[0], s0[1]), mx1 = fmaxf(s1[0], s1[1]);
#pragma unroll
                    for (int i = 2; i < 16; i += 2) { mx = fmaxf(fmaxf(mx, s0[i]), s0[i + 1]); mx1 = fmaxf(fmaxf(mx1, s1[i]), s1[i + 1]); }
                    mx = fmaxf(mx, mx1);
                    { const auto sw = __builtin_amdgcn_permlane32_swap(__float_as_uint(mx), __float_as_uint(mx), false, false);
                      mx = fmaxf(__uint_as_float(sw[0]), __uint_as_float(sw[1])); }
                    if (tile == 0 || __any(mx > 8.f)) {
                        const float d = (tile == 0 || mx > 8.f) ? mx : 0.f;
                        const float alpha = __builtin_amdgcn_exp2f(-d);
                        lsum *= alpha;
#pragma unroll
                        for (int i = 0; i < 16; ++i) { O0[i] *= alpha; O1[i] *= alpha; s0[i] -= d; s1[i] -= d; negm[i] -= d; }
                    }
                    }
                    float r0 = 0.f, r1 = 0.f, r2 = 0.f, r3 = 0.f;
#pragma unroll
                    for (int i = 0; i < 16; i += 2) {
                        s0[i] = __builtin_amdgcn_exp2f(s0[i]); s0[i + 1] = __builtin_amdgcn_exp2f(s0[i + 1]); s1[i] = __builtin_amdgcn_exp2f(s1[i]); s1[i + 1] = __builtin_amdgcn_exp2f(s1[i + 1]);
                        r0 += s0[i]; asm("" : "+v"(r0)); r1 += s0[i + 1]; asm("" : "+v"(r1)); r2 += s1[i]; asm("" : "+v"(r2)); r3 += s1[i + 1]; asm("" : "+v"(r3));
                    }
                    lsum += (r0 + r1) + (r2 + r3);
                    bf16x8 pf[4];
                    {
                        u32x4 t;
                        t.x = pack2(s0[0], s0[1]); t.y = pack2(s0[2], s0[3]); t.z = pack2(s0[4], s0[5]); t.w = pack2(s0[6], s0[7]); pf[0] = __builtin_bit_cast(bf16x8, t);
                        t.x = pack2(s0[8], s0[9]); t.y = pack2(s0[10], s0[11]); t.z = pack2(s0[12], s0[13]); t.w = pack2(s0[14], s0[15]); pf[1] = __builtin_bit_cast(bf16x8, t);
                        t.x = pack2(s1[0], s1[1]); t.y = pack2(s1[2], s1[3]); t.z = pack2(s1[4], s1[5]); t.w = pack2(s1[6], s1[7]); pf[2] = __builtin_bit_cast(bf16x8, t);
                        t.x = pack2(s1[8], s1[9]); t.y = pack2(s1[10], s1[11]); t.z = pack2(s1[12], s1[13]); t.w = pack2(s1[14], s1[15]); pf[3] = __builtin_bit_cast(bf16x8, t);
                    }
#pragma unroll
                    for (int ks = 0; ks < 4; ++ks) { O0 = mfma32(vf[2 * ks], pf[ks], O0); O1 = mfma32(vf[2 * ks + 1], pf[ks], O1); }
                }
            }
            if (more) {
                bf16_t* kw = Ks + (buf ^ 1) * 128 * 104; bf16_t* vw = Vs + (buf ^ 1) * 64 * 136;
#pragma unroll
                for (int i = 0; i < 3; ++i) *(u32x4*)(kw + koff_l[i]) = rk[i];
#pragma unroll
                for (int i = 0; i < 2; ++i) *(u32x4*)(vw + voff_l(i)) = rv[i];
            }
            __syncthreads();
        }
        const float lt = lsum + __shfl_xor(lsum, 32);
        if (!trk) { const int bad = !(lt > 0.f && lt < 1e37f); if (__syncthreads_or(bad)) { if (tid == 0) sh_u[1] = 1; continue; } }
        const float inv = 1.f / lt;
        bf16_t* op = (bf16_t*)(p.ws + XH) + (size_t)(q0 + w * 32 + l31) * 1024 + h * 64 + lh * 4;
#pragma unroll
        for (int gq = 0; gq < 4; ++gq) {
            u32x2 a; a.x = pack2(O0[gq * 4] * inv, O0[gq * 4 + 1] * inv); a.y = pack2(O0[gq * 4 + 2] * inv, O0[gq * 4 + 3] * inv); *(u32x2*)(op + gq * 8) = a;
            u32x2 b; b.x = pack2(O1[gq * 4] * inv, O1[gq * 4 + 1] * inv); b.y = pack2(O1[gq * 4 + 2] * inv, O1[gq * 4 + 3] * inv); *(u32x2*)(op + 32 + gq * 8) = b;
        }
        break;
        }
    }
    }
}

DI void gl_phase(const Params& p, char* smem) {
    const int tid = tid_fresh(), lane = tid & 63, w = tid >> 6, mt = w & 3, kh = w >> 2, lr = lane & 15, lq = lane >> 4;
    float* part = (float*)smem;
    for (int ch = blockIdx.x; ch < 256; ch += gridDim.x) {
        const bf16_t* xa = (const bf16_t*)(p.ws + XH) + (size_t)(ch * 64 + mt * 16 + lr) * 1024 + kh * 512 + lq * 8;
        const bf16_t* wb = (const bf16_t*)(p.ws + W_GL) + (size_t)lr * 1024 + kh * 512 + lq * 8;
        bf16x8 xf[16], wf[16];
#pragma unroll
        for (int ks = 0; ks < 16; ++ks) { xf[ks] = *(const bf16x8*)(xa + ks * 32); wf[ks] = *(const bf16x8*)(wb + ks * 32); }
        f32x4 acc = (f32x4){0.f, 0.f, 0.f, 0.f};
#pragma unroll
        for (int ks = 0; ks < 16; ++ks) acc = mfma16(wf[ks], xf[ks], acc);
        if (kh == 1) *(f32x4*)(part + (mt * 64 + lane) * 4) = acc;
        __syncthreads();
        if (kh == 0) { const f32x4 o = acc + *(const f32x4*)(part + (mt * 64 + lane) * 4); *(f32x4*)((float*)(p.ws + GL) + ((size_t)ch * 64 + mt * 16 + lr) * 16 + lq * 4) = o; }
        __syncthreads();
    }
}

constexpr int NPH = 19;
DI void run_phase(const Params& p, int ph, char* smem) {
    const int dup = ph >= 100; if (dup) ph -= 100;
    const int G = gridDim.x, b = blockIdx.x;
    bf16_t* xh = (bf16_t*)(p.ws + XH);
    switch (ph) {
    case 0: {
        const int total = p.jstart[NJOBS]; const int tidp = tid_fresh();
        for (int t0 = b * 3; t0 < total; t0 += G * 3) {
#pragma unroll
            for (int q = 0; q < 3; ++q) { const int t = t0 + q; if (t < total) { int j = 0; while (t >= p.jstart[j + 1]) ++j; tr_load(p.jobs[j], t - p.jstart[j], (float*)smem + q * 64 * 65, tidp); } }
            __syncthreads();
#pragma unroll
            for (int q = 0; q < 3; ++q) { const int t = t0 + q; if (t < total) { int j = 0; while (t >= p.jstart[j + 1]) ++j; tr_store(p.jobs[j], t - p.jstart[j], (const float*)smem + q * 64 * 65, tidp); } }
            __syncthreads();
        }
        norm_phase(p.x, xh);
        { float* rt = (float*)(p.ws + ROPET);
          for (int idx = b * NT + tid_fresh(); idx < S * 16; idx += G * NT) { const int s = idx >> 4, i = idx & 15; const float ang = (float)p.pos[s] * p.inv_freq[i]; rt[s * 32 + i] = cosf(ang); rt[s * 32 + 16 + i] = sinf(ang); } }
    } break;
    case 1: { Epi<EPI_INPROJ> E{}; E.o0 = (bf16_t*)(p.ws + QK); E.o1 = (bf16_t*)(p.ws + VT); E.o2 = (bf16_t*)(p.ws + RB); E.outf = (float*)(p.ws + GL);
        gemm_phase<EPI_INPROJ>(xh, (const bf16_t*)(p.ws + W_IN), 3072, 1024, E, smem); gl_phase(p, smem); } break;
    case 2: { const int hf2 = tid_fresh() >> 8; for (int u0 = b * 2; u0 < 1024; u0 += 2 * G) gla_kv_unit(p, u0 + hf2, smem + hf2 * 53248); } break;
    case 3: gla_scan(p); break;
    case 4: { const int hf2 = tid_fresh() >> 8; for (int u0 = b * 2; u0 < 1024; u0 += 2 * G) gla_out_unit(p, u0 + hf2, smem + hf2 * 53248); } break;
    case 5: case 15: if (G == 256) { EpiResNorm E{}; E.res = ph == 5 ? p.x : p.out; E.outf = p.out; E.xh = xh; E.xbuf = (float*)(p.ws + XSLOT) + (ph == 5 ? 0 : 2 * 4 * S); E.cnt = (unsigned*)(p.ws + PCNT) + (ph == 5 ? 0 : 2 * 4096);
            gemm_phase_resnorm(xh, (const bf16_t*)(p.ws + (ph == 5 ? W_AOUT : W_BOUT)), 1024, E, smem); }
        else { Epi<EPI_RES> E{}; E.res = ph == 5 ? p.x : p.out; E.outf = p.out;
            gemm_phase<EPI_RES>(xh, (const bf16_t*)(p.ws + (ph == 5 ? W_AOUT : W_BOUT)), 1024, 1024, E, smem); } break;
    case 6: case 9: case 16: norm_phase(p.out, xh); break;
    case 7: case 17: { const int l = ph == 17; Epi<EPI_SWIGLU> E{}; E.o0 = (bf16_t*)(p.ws + HB);
        gemm_phase<EPI_SWIGLU>(xh, (const bf16_t*)(p.ws + W_FIN) + (size_t)l * 5632 * 1024, 5632, 1024, E, smem); } break;
    case 8: if (G == 256) { EpiResNorm E{}; E.res = p.out; E.outf = p.out; E.xh = xh; E.xbuf = (float*)(p.ws + XSLOT) + 4 * S; E.cnt = (unsigned*)(p.ws + PCNT) + 4096;
            gemm_phase_resnorm((const bf16_t*)(p.ws + HB), (const bf16_t*)(p.ws + W_FOUT), 2816, E, smem); break; }
    case 18: { const int l = ph == 18; Epi<EPI_RES> E{}; E.res = p.out; E.outf = p.out;
        gemm_phase<EPI_RES>((const bf16_t*)(p.ws + HB), (const bf16_t*)(p.ws + W_FOUT) + (size_t)l * 1024 * 2816, 1024, 2816, E, smem); } break;
    case 10: if (G == 256) { EpiLatent E{}; E.ckv = (bf16_t*)(p.ws + CKV); E.cq = (bf16_t*)(p.ws + CQ); E.krope = (float*)(p.ws + KROPE); E.xbuf = (float*)(p.ws + XSLOT) + 3 * 4 * S; E.cnt = (unsigned*)(p.ws + PCNT) + 3 * 4096; E.ropet = (const float*)(p.ws + ROPET); E.kgain = p.k_norm; E.krss = (float*)(p.ws + KRSS);
            gemm_phase_latent(xh, (const bf16_t*)(p.ws + W_DD), E, smem); }
        else { Epi<EPI_F32> E{}; E.outf = (float*)(p.ws + DBUF); E.ldo = 768;
            gemm_phase<EPI_F32>(xh, (const bf16_t*)(p.ws + W_DD), 768, 1024, E, smem); } break;
    case 11: latent_norm_phase(p); break;
    case 12: {
        if (G == 256) { EpiKV2 E{}; E.kb = (bf16_t*)(p.ws + KB); E.vt = (bf16_t*)(p.ws + VTM); E.krss = (const float*)(p.ws + KRSS); E.krope = (const float*)(p.ws + KROPE);
          gemm_phase_kv2((const bf16_t*)(p.ws + CKV), (const bf16_t*)(p.ws + W_UP), E, smem); }
        else { Epi<EPI_KV> E{}; E.o0 = (bf16_t*)(p.ws + KB); E.o1 = (bf16_t*)(p.ws + VTM);
          gemm_phase<EPI_KV>((const bf16_t*)(p.ws + CKV), (const bf16_t*)(p.ws + W_UP), 2048, 256, E, smem); }
        { Epi<EPI_BF16> E{}; E.o0 = (bf16_t*)(p.ws + QB); E.ldo = 1536;
          gemm_phase<EPI_BF16>((const bf16_t*)(p.ws + CQ), (const bf16_t*)(p.ws + W_UQ), 1536, 384, E, smem); }
    } break;
    case 13: qk_post_phase(p); break;
    case 14: attn_phase(p, smem, dup, G == 256); break;
    default: break;
    }
}

__global__ void __launch_bounds__(NT, 2) yoco_mega(const Params p) {
    extern __shared__ __attribute__((aligned(16))) char smem[];
#if MULTI_LAUNCH
    run_phase(p, p.ph_lo, smem);
#else
    cg::grid_group grid = cg::this_grid();
    __shared__ uint4 xb_words;
    if (threadIdx.x == 0) xb_words = make_uint4(0u, 0u, 0u, 0u);
    __syncthreads();
    XcdBarrier xb = xcd_barrier_post((unsigned*)(p.ws + MISC_BAR), (volatile LAS unsigned*)&xb_words);
    if (p.ph_hi == 0x7fffffff) grid.sync();
    run_phase(p, 0, smem); xcd_barrier(xb);
#ifdef DUP0
    run_phase(p, 0, smem); xcd_barrier(xb);
#endif
#ifndef DUP
#define DUP 0
#endif
#define PHASE(n) run_phase(p, n, smem); xcd_barrier(xb); if ((DUP >> n) & 1) { run_phase(p, n + 100, smem); xcd_barrier(xb); }
    PHASE(1) PHASE(2) PHASE(3) PHASE(4)
#ifdef DUPGLA
    PHASE(2) PHASE(3) PHASE(4)
#endif
    const bool fuse = gridDim.x == 256;
    PHASE(5) if (!fuse) { PHASE(6) } PHASE(7) PHASE(8) if (!fuse) { PHASE(9) }
    PHASE(10) if (!fuse) { PHASE(11) } PHASE(12) if (!fuse) { PHASE(13) } PHASE(14) PHASE(15) if (!fuse) { PHASE(16) } PHASE(17)
    run_phase(p, 18, smem);
#undef PHASE
#endif
}

extern "C" void kernel_launch(void* const* d_in, const int* in_sizes, int n_in, void* d_out, int out_size, void* d_ws, size_t ws_size, hipStream_t stream) {
    static int grid_blocks = 0;
    if (grid_blocks == 0) {
        if (n_in != 22 || ws_size < WS_NEED) { fprintf(stderr, "kernel_launch: unexpected n_in %d / ws %zu (need %zu)\n", n_in, ws_size, (size_t)WS_NEED); grid_blocks = -1; return; }
        int dev = 0, cus = 0, per_cu = 0;
        hipGetDevice(&dev); hipDeviceGetAttribute(&cus, hipDeviceAttributeMultiprocessorCount, dev);
        if (hipFuncSetAttribute((const void*)yoco_mega, hipFuncAttributeMaxDynamicSharedMemorySize, LDS_BYTES) != hipSuccess) { fprintf(stderr, "kernel_launch: hipFuncSetAttribute failed\n"); grid_blocks = -1; return; }
        if (hipOccupancyMaxActiveBlocksPerMultiprocessor(&per_cu, (const void*)yoco_mega, NT, LDS_BYTES) != hipSuccess || per_cu < 1) { fprintf(stderr, "kernel_launch: occupancy query failed (%d)\n", per_cu); grid_blocks = -1; return; }
        if (per_cu > 1) per_cu = 1;
        grid_blocks = cus * per_cu;
        fprintf(stderr, "kernel_launch: cus %d per_cu %d grid %d\n", cus, per_cu, grid_blocks);
    }
    if (grid_blocks < 0) return;
    Params p; memset(&p, 0, sizeof(p));
    p.x = (const float*)d_in[0]; p.pos = (const int*)d_in[1];
    p.a_norm = (const float*)d_in[2]; p.a_w_in = (const float*)d_in[3]; p.a_w_gate_up = (const float*)d_in[4]; p.a_b_gate = (const float*)d_in[5]; p.a_out_norm = (const float*)d_in[6]; p.a_w_out = (const float*)d_in[7];
    p.b_norm = (const float*)d_in[8]; p.b_w_dq = (const float*)d_in[9]; p.b_q_latent_norm = (const float*)d_in[10]; p.b_w_uq = (const float*)d_in[11]; p.b_q_norm = (const float*)d_in[12]; p.b_w_out = (const float*)d_in[13];
    p.kv_norm = (const float*)d_in[14]; p.kv_w_down = (const float*)d_in[15]; p.kv_latent_norm = (const float*)d_in[16]; p.kv_w_up = (const float*)d_in[17]; p.k_norm = (const float*)d_in[18];
    p.f_norm = (const float*)d_in[19]; p.f_w_in = (const float*)d_in[20]; p.f_w_out = (const float*)d_in[21];
    p.out = (float*)d_out; p.ws = (char*)d_ws;
    char* ws = (char*)d_ws;
    auto job = [&](int i, const float* src, const float* gain, size_t dst, int ldn, int col0, int nvalid, int nrows, int K, int mode) {
        p.jobs[i].src = src; p.jobs[i].gain = gain; p.jobs[i].dst = (bf16_t*)(ws + dst); p.jobs[i].ldn = ldn; p.jobs[i].col0 = col0; p.jobs[i].nvalid = nvalid; p.jobs[i].nrows = nrows; p.jobs[i].K = K; p.jobs[i].mode = mode; };
    job(0, p.a_w_in, p.a_norm, W_IN, 3088, 0, 3072, 3072, 1024, 0);
    job(12, p.a_w_in, p.a_norm, W_GL, 3088, 3072, 16, 64, 1024, 0);
    job(1, p.a_w_out, nullptr, W_AOUT, 1024, 0, 1024, 1024, 1024, 0);
    job(2, p.f_w_in, p.f_norm, W_FIN, 5632, 0, 5632, 5632, 1024, 1);
    job(3, p.f_w_in + (size_t)1024 * 5632, p.f_norm + 1024, W_FIN + (size_t)5632 * 1024 * 2, 5632, 0, 5632, 5632, 1024, 1);
    job(4, p.f_w_out, nullptr, W_FOUT, 1024, 0, 1024, 1024, 2816, 0);
    job(5, p.f_w_out + (size_t)2816 * 1024, nullptr, W_FOUT + (size_t)1024 * 2816 * 2, 1024, 0, 1024, 1024, 2816, 0);
    job(6, p.kv_w_down, p.kv_norm, W_DD, 288, 0, 256, 256, 1024, 0);
    job(7, p.b_w_dq, p.b_norm, W_DD + (size_t)256 * 1024 * 2, 384, 0, 384, 384, 1024, 0);
    job(8, p.kv_w_down, p.kv_norm, W_DD + (size_t)640 * 1024 * 2, 288, 256, 32, 128, 1024, 0);
    job(9, p.kv_w_up, p.kv_latent_norm, W_UP, 2048, 0, 2048, 2048, 256, grid_blocks == 256 ? 2 : 0);
    job(10, p.b_w_uq, p.b_q_latent_norm, W_UQ, 1536, 0, 1536, 1536, 384, 0);
    job(11, p.b_w_out, nullptr, W_BOUT, 1024, 0, 1024, 1024, 1024, 0);
    p.jstart[0] = 0;
    for (int i = 0; i < NJOBS; ++i) p.jstart[i + 1] = p.jstart[i] + (p.jobs[i].nrows / 64) * (p.jobs[i].K / 64);
    for (int i = 0; i < 16; ++i) p.inv_freq[i] = (float)pow(10000.0, -(double)i / 16.0);
    if (hipMemsetAsync(ws + MISC, 0, MISC_ZERO_BYTES, stream) != hipSuccess) fprintf(stderr, "kernel_launch: memset failed\n");
#if MULTI_LAUNCH
    for (int ph = 0; ph < NPH; ++ph) { p.ph_lo = ph; p.ph_hi = ph + 1; hipLaunchKernelGGL(yoco_mega, dim3(grid_blocks), dim3(NT), LDS_BYTES, stream, p); }
#else
    void* args[] = {(void*)&p};
    hipError_t e = hipLaunchCooperativeKernel((const void*)yoco_mega, dim3(grid_blocks), dim3(NT), args, LDS_BYTES, stream);
    if (e != hipSuccess) fprintf(stderr, "kernel_launch: cooperative launch failed: %s (grid %d)\n", hipGetErrorString(e), grid_blocks);
#endif
}
```
